# Optimizing an MI355X kernel written in HIP

```python
import jax, jax.numpy as jnp
from jax import lax
import numpy as np

D_MODEL = 1024
BATCH = 8
SEQ = 8192
DEPTH = 4

CTX_LEN = 256
GRID_W = 64
D_MIX = D_MODEL
D_HGRN = D_MIX // 2
HGRN_HEAD_DIM = 128
HGRN_HEADS = D_HGRN // HGRN_HEAD_DIM
HGRN_CHUNK = 16
D_POOL = D_MIX - D_HGRN
POOL_WINDOWS = (2, 4, 8, 16)
POOL_GROUPS = len(POOL_WINDOWS)
POOL_GROUP_DIM = D_POOL // POOL_GROUPS
D_IN = 5 * D_HGRN + D_POOL
D_FF_DENSE = 2816
N_EXPERTS = 8
TOP_K = 2
D_FF_EXPERT = 3584
N_ADA = 6
EPS = 1e-6

kernel_name = "hybrid_hgrn2_pool_moe_dit_trunk"


def rms_norm(x, w):
    xf = x.astype(jnp.float32)
    y = xf * lax.rsqrt(jnp.mean(xf * xf, axis=-1, keepdims=True) + EPS)
    return (y * w.astype(jnp.float32)).astype(x.dtype)


def modulate(h, shift, scale):
    return h * (1 + scale) + shift


def gla_chunk_scan(q, k, v, log_f, state0):
    B, L, H, DK = q.shape
    DV = v.shape[-1]
    C = HGRN_CHUNK
    nc = L // C

    def chunks(a):
        return a.reshape(B, nc, C, H, a.shape[-1]).transpose(1, 0, 3, 2, 4)

    incl = jnp.tril(jnp.ones((C, C), dtype=bool))[:, :, None]

    def step(state, blk):
        qb, kb, vb, gb = blk
        b = jnp.cumsum(gb, axis=2)
        rel = jnp.where(incl, b[:, :, :, None, :] - b[:, :, None, :, :], -jnp.inf)
        scores = jnp.einsum('bhtk,bhsk,bhtsk->bhts', qb, kb, jnp.exp(rel))
        o = (jnp.einsum('bhts,bhsv->bhtv', scores, vb)
             + jnp.einsum('bhtk,bhkv->bhtv', qb * jnp.exp(b), state))
        b_end = b[:, :, -1:, :]
        state = (jnp.exp(b_end[:, :, 0, :, None]) * state
                 + jnp.einsum('bhsk,bhsv->bhkv', kb * jnp.exp(b_end - b), vb))
        return state, o

    state, o = lax.scan(step, state0, tuple(map(chunks, (q, k, v, log_f))))
    return o.transpose(1, 0, 3, 2, 4).reshape(B, L, H, DV), state


def hgrn_inputs(z, lb):
    B, L = z.shape[:2]
    q, i, f_fwd, f_bwd, g = jnp.split(z, 5, axis=-1)
    heads = lambda a: a.reshape(B, L, HGRN_HEADS, HGRN_HEAD_DIM)
    log_fs, ks = [], []
    for d, zf in enumerate((f_fwd, f_bwd)):
        f = lb[d] + (1 - lb[d]) * jax.nn.sigmoid(zf)
        log_fs.append(heads(jnp.log(f)))
        ks.append(heads(1 - f))
    return heads(q) * HGRN_HEAD_DIM ** -0.5, heads(i), log_fs, ks, g


def hgrn_readout(o, g, w):
    B, L = o.shape[:2]
    o = o * lax.rsqrt(jnp.mean(o * o, axis=-1, keepdims=True) + EPS) * w.reshape(HGRN_HEADS, HGRN_HEAD_DIM)
    return o.reshape(B, L, D_HGRN) * jax.nn.silu(g)


def hgrn_mixer(z_ctx, z_lat, lb, out_norm_w):
    q_c, i_c, lf_c, k_c, g_c = hgrn_inputs(z_ctx, lb)
    q_l, i_l, lf_l, k_l, g_l = hgrn_inputs(z_lat, lb)
    B = z_lat.shape[0]
    state0 = jnp.zeros((B, HGRN_HEADS, HGRN_HEAD_DIM, HGRN_HEAD_DIM), jnp.float32)
    o_ctx, o_lat = 0.0, 0.0
    for d in range(2):
        rev = (lambda a: jnp.flip(a, axis=1)) if d else (lambda a: a)
        oc, s_ctx = gla_chunk_scan(rev(q_c), rev(k_c[d]), rev(i_c), rev(lf_c[d]), state0)
        ol, _ = gla_chunk_scan(rev(q_l), rev(k_l[d]), rev(i_l), rev(lf_l[d]), s_ctx)
        o_ctx = o_ctx + rev(oc)
        o_lat = o_lat + rev(ol)
    return hgrn_readout(o_ctx, g_c, out_norm_w), hgrn_readout(o_lat, g_l, out_norm_w)


def centred_window_sum(x, axis, k):
    n = x.shape[axis]
    lo, hi = k // 2, k - 1 - k // 2
    cs = jnp.cumsum(x, axis=axis)
    cs = jnp.concatenate([jnp.zeros_like(lax.slice_in_dim(cs, 0, 1, axis=axis)), cs], axis=axis)
    pos = np.arange(n)
    end = np.minimum(pos + hi + 1, n)
    start = np.maximum(pos - lo, 0)
    total = jnp.take(cs, end, axis=axis) - jnp.take(cs, start, axis=axis)
    return total, (end - start).astype(np.float32)


def pool_latent(v):
    B, T = v.shape[:2]
    rows = T // GRID_W
    grid = v.reshape(B, rows, GRID_W, POOL_GROUPS, POOL_GROUP_DIM)
    means = []
    for j, k in enumerate(POOL_WINDOWS):
        s_col, n_col = centred_window_sum(grid[:, :, :, j, :], 2, k)
        s, n_row = centred_window_sum(s_col, 1, k)
        means.append(s / (n_row[:, None] * n_col[None, :])[None, :, :, None])
    return jnp.stack(means, axis=3).reshape(B, T, POOL_GROUPS, POOL_GROUP_DIM) - v


def pool_context(v):
    means = []
    for j, k in enumerate(POOL_WINDOWS):
        s, n = centred_window_sum(v[:, :, j, :], 1, k)
        means.append(s / n[None, :, None])
    return jnp.stack(means, axis=2) - v


def pool_mixer(diff, w, scale):
    B, L = diff.shape[:2]
    return jnp.einsum('blgc,gcd->blgd', diff, w).reshape(B, L, D_POOL) * scale


def swiglu(h, wg, wu, wd):
    return (jax.nn.silu(h @ wg) * (h @ wu)) @ wd


def moe_swiglu(h, w_router, wg, wu, wd):
    logits = jnp.einsum('bld,de->ble', h.astype(jnp.float32), w_router.astype(jnp.float32))
    top_logits, top_idx = lax.top_k(logits, TOP_K)
    top_w = jax.nn.softmax(top_logits, axis=-1)
    combine = jnp.einsum('blk,blke->ble', top_w, jax.nn.one_hot(top_idx, N_EXPERTS, dtype=jnp.float32))
    out = jnp.zeros(h.shape, jnp.float32)
    for e in range(N_EXPERTS):
        out = out + combine[..., e:e + 1] * swiglu(h, wg[e], wu[e], wd[e]).astype(jnp.float32)
    return out


def setup_inputs(seed: int = 0) -> dict:
    key = jax.random.key(seed)
    ks = jax.random.split(key, 24)
    n_dense, n_moe = (DEPTH + 1) // 2, DEPTH // 2
    f32 = jnp.float32
    nrm = lambda k, shape: jax.random.normal(k, shape, f32)
    return {
        "x": nrm(ks[0], (BATCH, SEQ, D_MODEL)),
        "c": nrm(ks[1], (BATCH, D_MODEL)),
        "ctx": nrm(ks[2], (BATCH, CTX_LEN, D_MODEL)),
        "c_ctx": nrm(ks[3], (D_MODEL,)),
        "w_ada": nrm(ks[4], (DEPTH, D_MODEL, N_ADA * D_MODEL)) * 0.5 * D_MODEL ** -0.5,
        "b_ada": nrm(ks[5], (DEPTH, N_ADA * D_MODEL)) * 0.02,
        "norm_w": 1 + 0.1 * nrm(ks[6], (DEPTH, 2, D_MODEL)),
        "w_in": nrm(ks[7], (DEPTH, D_MODEL, D_IN)) * D_MODEL ** -0.5,
        "hgrn_lb_raw": 0.5 * nrm(ks[8], (DEPTH, 2, D_HGRN)),
        "hgrn_norm_w": 1 + 0.1 * nrm(ks[9], (DEPTH, D_HGRN)),
        "w_pool": nrm(ks[10], (DEPTH, POOL_GROUPS, POOL_GROUP_DIM, POOL_GROUP_DIM)) * POOL_GROUP_DIM ** -0.5,
        "pool_scale": 0.5 + 0.1 * nrm(ks[11], (DEPTH, D_POOL)),
        "w_out": nrm(ks[12], (DEPTH, D_MIX, D_MODEL)) * D_MIX ** -0.5,
        "ffn_wg": nrm(ks[13], (n_dense, D_MODEL, D_FF_DENSE)) * D_MODEL ** -0.5,
        "ffn_wu": nrm(ks[14], (n_dense, D_MODEL, D_FF_DENSE)) * D_MODEL ** -0.5,
        "ffn_wd": nrm(ks[15], (n_dense, D_FF_DENSE, D_MODEL)) * D_FF_DENSE ** -0.5,
        "router_w": nrm(ks[16], (n_moe, D_MODEL, N_EXPERTS)) * D_MODEL ** -0.5,
        "moe_wg": nrm(ks[17], (n_moe, N_EXPERTS, D_MODEL, D_FF_EXPERT)) * D_MODEL ** -0.5,
        "moe_wu": nrm(ks[18], (n_moe, N_EXPERTS, D_MODEL, D_FF_EXPERT)) * D_MODEL ** -0.5,
        "moe_wd": nrm(ks[19], (n_moe, N_EXPERTS, D_FF_EXPERT, D_MODEL)) * D_FF_EXPERT ** -0.5,
        "final_norm_w": 1 + 0.1 * nrm(ks[20], (D_MODEL,)),
    }


def reference(x, c, ctx, c_ctx, w_ada, b_ada, norm_w, w_in, hgrn_lb_raw, hgrn_norm_w, w_pool,
              pool_scale, w_out, ffn_wg, ffn_wu, ffn_wd, router_w, moe_wg, moe_wu, moe_wd,
              final_norm_w):
    f32 = jnp.float32
    B, T, D = x.shape
    Lc = ctx.shape[1]
    lb_cum = jnp.cumsum(jax.nn.softmax(hgrn_lb_raw.astype(f32), axis=0), axis=0)
    lower_bounds = lb_cum - lb_cum[:1]
    h_lat, h_ctx = x, ctx
    for l in range(DEPTH):
        last = l == DEPTH - 1
        mod_l = (jax.nn.silu(c) @ w_ada[l] + b_ada[l]).reshape(B, N_ADA, 1, D)
        mod_c = (jax.nn.silu(c_ctx) @ w_ada[l] + b_ada[l]).reshape(N_ADA, 1, 1, D)
        u_lat = modulate(rms_norm(h_lat, norm_w[l, 0]), mod_l[:, 0], mod_l[:, 1])
        u_ctx = modulate(rms_norm(h_ctx, norm_w[l, 0]), mod_c[0], mod_c[1])
        z = (jnp.concatenate([u_ctx, u_lat], axis=1) @ w_in[l]).astype(f32)
        z_ctx, z_lat = z[:, :Lc], z[:, Lc:]
        a_ctx, a_lat = hgrn_mixer(z_ctx[..., :5 * D_HGRN], z_lat[..., :5 * D_HGRN],
                                  lower_bounds[l], hgrn_norm_w[l])
        pv_lat = z_lat[..., 5 * D_HGRN:].reshape(B, T, POOL_GROUPS, POOL_GROUP_DIM)
        p_lat = pool_mixer(pool_latent(pv_lat), w_pool[l], pool_scale[l])
        y_lat = jnp.concatenate([a_lat, p_lat], axis=-1) @ w_out[l]
        h_lat = h_lat + (mod_l[:, 2] * y_lat).astype(h_lat.dtype)
        if not last:
            pv_ctx = z_ctx[..., 5 * D_HGRN:].reshape(B, Lc, POOL_GROUPS, POOL_GROUP_DIM)
            p_ctx = pool_mixer(pool_context(pv_ctx), w_pool[l], pool_scale[l])
            y_ctx = jnp.concatenate([a_ctx, p_ctx], axis=-1) @ w_out[l]
            h_ctx = h_ctx + (mod_c[2] * y_ctx).astype(h_ctx.dtype)
        v = modulate(rms_norm(h_lat, norm_w[l, 1]), mod_l[:, 3], mod_l[:, 4])
        if not last:
            v = jnp.concatenate([modulate(rms_norm(h_ctx, norm_w[l, 1]), mod_c[3], mod_c[4]), v], axis=1)
        if l % 2 == 0:
            y = swiglu(v, ffn_wg[l // 2], ffn_wu[l // 2], ffn_wd[l // 2])
        else:
            y = moe_swiglu(v, router_w[l // 2], moe_wg[l // 2], moe_wu[l // 2], moe_wd[l // 2])
        h_lat = h_lat + (mod_l[:, 5] * y[:, -T:]).astype(h_lat.dtype)
        if not last:
            h_ctx = h_ctx + (mod_c[5] * y[:, :Lc]).astype(h_ctx.dtype)
    return rms_norm(h_lat, final_norm_w)
```

```cpp
#include <hip/hip_runtime.h>
#include <cstdio>
#include <cstdint>

#ifndef MK_ONE_LAUNCH
#define MK_ONE_LAUNCH 1
#endif

#define LAS __attribute__((address_space(3)))
typedef unsigned short bf16;
typedef short bf16x8 __attribute__((ext_vector_type(8)));
typedef float f32x4 __attribute__((ext_vector_type(4)));
typedef float f32x2 __attribute__((ext_vector_type(2)));
typedef unsigned u32x4 __attribute__((ext_vector_type(4)));
typedef unsigned u32x2 __attribute__((ext_vector_type(2)));

constexpr int NB = 8, SEQ = 8192, D = 1024, LC = 256, DEPTH = 4;
constexpr int NCTX = NB * LC;
constexpr int NLAT = NB * SEQ;
constexpr int NTOK = NCTX + NLAT;
constexpr int DH = 512, NH = 4;
constexpr int DIN = 3072, ZW = 1536;
constexpr int DFF = 2816, DFE = 3584, NE = 8;
constexpr int NCHUNK = 132;
constexpr int NUNIT_P0 = NB * NH * 2 * NCHUNK;
constexpr float EPS = 1e-6f;
constexpr float QSCALE = 0.08838834764831845f;
constexpr int MOE_TILES_CAP = 272;
constexpr int NTHR = 512;

constexpr size_t MiB = (size_t)1 << 20;
constexpr size_t WS_CTL = 0, CTL_BYTES = 1 * MiB;
constexpr size_t WS_MODS = 1 * MiB;
constexpr size_t WS_LB = 2 * MiB;
constexpr size_t WS_META = 2 * MiB + 65536;
constexpr size_t WS_RS = 2 * MiB + 131072;
constexpr size_t WS_SRS = 6 * MiB;
constexpr size_t WS_ROUTE = 3 * MiB;
constexpr size_t WS_LIST = 5 * MiB;
constexpr size_t WS_HCTX = 8 * MiB;
constexpr size_t WS_HL0 = 148 * MiB;
constexpr size_t WS_HL1 = 1011 * MiB;
constexpr size_t WS_WIN = 16 * MiB;
constexpr size_t WS_WOUT = 40 * MiB;
constexpr size_t WS_WF1 = 48 * MiB;
constexpr size_t WS_WF2 = 70 * MiB;
constexpr size_t WS_R1 = 82 * MiB;
constexpr size_t WS_BIG = 214 * MiB;
constexpr size_t WS_ZA = WS_BIG;
constexpr size_t WS_ZB = WS_BIG + 198 * MiB;
constexpr size_t WS_QF = WS_BIG + 396 * MiB;
constexpr size_t WS_KF = WS_QF + 132 * MiB;
constexpr size_t WS_AF = WS_KF + 132 * MiB;
constexpr size_t WS_VF = WS_AF + 66 * MiB;
constexpr size_t WS_DEC = WS_VF + 66 * MiB;
constexpr size_t WS_POOL1 = WS_ZA + 132 * MiB;
constexpr size_t WS_ACT = WS_BIG;
constexpr size_t WS_YB = WS_BIG + 476 * MiB;
constexpr size_t WS_WM1 = 1075 * MiB;
constexpr size_t WS_WM2 = WS_WM1 + 56 * MiB;
constexpr size_t WS_END = WS_WM2 + 28 * MiB;
static_assert(WS_DEC + 5 * MiB <= WS_HL1 && WS_HL1 + 64 * MiB <= WS_WM1 && WS_POOL1 + 64 * MiB <= WS_ZB && WS_R1 + 66 * MiB <= WS_HL0 && WS_HL0 + 64 * MiB <= WS_BIG, "ws map");
static_assert(WS_END == 1159 * MiB && WS_YB + 264 * MiB <= WS_WM1 && WS_YB >= WS_ACT + 476 * MiB, "ws map");

constexpr int LDS_BYTES = 147456;
constexpr int LDS_MISC = LDS_BYTES - 256;

typedef __bf16 bf16x2_t __attribute__((ext_vector_type(2)));
__device__ __forceinline__ unsigned pk2(float lo, float hi) { const f32x2 v = {lo, hi}; const bf16x2_t b = __builtin_convertvector(v, bf16x2_t); return __builtin_bit_cast(unsigned, b); }
__device__ __forceinline__ unsigned pk4_i8(float a, float b, float c, float d) {
    const float M = 12582912.0f;
    const unsigned ua = __builtin_bit_cast(unsigned, __builtin_amdgcn_fmed3f(a, -127.f, 127.f) + M), ub = __builtin_bit_cast(unsigned, __builtin_amdgcn_fmed3f(b, -127.f, 127.f) + M);
    const unsigned uc = __builtin_bit_cast(unsigned, __builtin_amdgcn_fmed3f(c, -127.f, 127.f) + M), ud = __builtin_bit_cast(unsigned, __builtin_amdgcn_fmed3f(d, -127.f, 127.f) + M);
    return __builtin_amdgcn_perm(ub, ua, 0x0c0c0400u) | __builtin_amdgcn_perm(ud, uc, 0x04000c0cu); }
constexpr float Q_SA = 127.f / 8.f, Q_SW1 = 127.f / 0.1406250f, Q_SW2 = 127.f / 0.0751671f, Q_SW2D = 127.f / 0.0847998f;
__device__ __forceinline__ bf16* hlat_row(unsigned char* ws, int rr) { return (bf16*)(ws + (rr < 32768 ? WS_HL0 : WS_HL1)) + (size_t)(rr & 32767) * D; }
__device__ __forceinline__ bf16 f2bf(float x) { return (bf16)(pk2(x, 0.f) & 0xffffu); }
__device__ __forceinline__ float bf2f(bf16 x) { return __uint_as_float(((unsigned)x) << 16); }
__device__ __forceinline__ float bflo(unsigned w) { return __uint_as_float(w << 16); }
__device__ __forceinline__ float bfhi(unsigned w) { return __uint_as_float(w & 0xffff0000u); }
__device__ __forceinline__ float siluf(float x) { return x * __builtin_amdgcn_rcpf(1.0f + __expf(-x)); }
#define DPP_F(v, ctrl) __builtin_bit_cast(float, __builtin_amdgcn_update_dpp(0, __builtin_bit_cast(int, (v)), (ctrl), 0xf, 0xf, false))
__device__ __forceinline__ float row16_sum(float v) {
    v += DPP_F(v, 0xB1);
    v += DPP_F(v, 0x4E);
    v += DPP_F(v, 0x124);
    v += DPP_F(v, 0x128);
    return v; }
__device__ __forceinline__ float wave_max(float v) {
    v = fmaxf(v, DPP_F(v, 0xB1)); v = fmaxf(v, DPP_F(v, 0x4E)); v = fmaxf(v, DPP_F(v, 0x124)); v = fmaxf(v, DPP_F(v, 0x128));
    const int i = __builtin_bit_cast(int, v);
    return fmaxf(fmaxf(__builtin_bit_cast(float, __builtin_amdgcn_readlane(i, 0)), __builtin_bit_cast(float, __builtin_amdgcn_readlane(i, 16))), fmaxf(__builtin_bit_cast(float, __builtin_amdgcn_readlane(i, 32)), __builtin_bit_cast(float, __builtin_amdgcn_readlane(i, 48)))); }
__device__ __forceinline__ float wave_sum(float v) {
    v = row16_sum(v);
    const int i = __builtin_bit_cast(int, v);
    return __builtin_bit_cast(float, __builtin_amdgcn_readlane(i, 0)) + __builtin_bit_cast(float, __builtin_amdgcn_readlane(i, 16)) + __builtin_bit_cast(float, __builtin_amdgcn_readlane(i, 32)) + __builtin_bit_cast(float, __builtin_amdgcn_readlane(i, 48)); }

#define XB_TMO      128
#define XB_XCNT(j)  (256  + 64 * (j))
#define XB_XSUB(j)  (1280 + 64 * (j))
#define XB_XGEN(j)  (2304 + 64 * (j))
#define XB_TOP      3328
#define XB_TOPGEN   3392
#define XCD_BAR_WORDS 3456
#define XB_SPIN_CAP (1u << 18)
#define LAS __attribute__((address_space(3)))

__device__ __forceinline__ unsigned xb_ld(unsigned* p)              { return __hip_atomic_load(p, __ATOMIC_RELAXED, __HIP_MEMORY_SCOPE_AGENT); }
__device__ __forceinline__ unsigned xb_add(unsigned* p, unsigned v) { return __hip_atomic_fetch_add(p, v, __ATOMIC_RELAXED, __HIP_MEMORY_SCOPE_AGENT); }
__device__ __forceinline__ unsigned xb_xcc_id() { return (unsigned)__builtin_amdgcn_s_getreg((3 << 11) | 20) & 0xFu; }
#define XB_SPIN(cond, bar) do { unsigned _sp = 0; while (cond) { __builtin_amdgcn_s_sleep(1); \
    if ((++_sp & 255u) == 0u) { if (xb_ld(&(bar)[XB_TMO])) break; if (_sp > XB_SPIN_CAP) { atomicAdd(&(bar)[XB_TMO], 1u); break; } } } } while (0)

struct XcdBarrier {
    unsigned* bar; unsigned x;
    volatile LAS unsigned* st;
};

__device__ __forceinline__ XcdBarrier xcd_barrier_post(unsigned* bar, volatile LAS unsigned* st) {
    XcdBarrier b; b.bar = bar; b.x = xb_xcc_id(); b.st = st;
    if (threadIdx.x == 0) (void)xb_add(&bar[XB_XCNT(b.x)], 1u);
    return b;
}
__device__ __forceinline__ void xcd_barrier_complete(unsigned* bar, unsigned x, unsigned& nloc, unsigned& nx) {
    const unsigned G = gridDim.x * gridDim.y * gridDim.z;
    unsigned sum, cnt, mine, sp = 0u;
    for (;;) {
        sum = 0u; cnt = 0u; mine = 0u;
#pragma unroll
        for (unsigned j = 0; j < 16; ++j) { const unsigned c = xb_ld(&bar[XB_XCNT(j)]); sum += c; cnt += (c > 0u) ? 1u : 0u; mine = (j == x) ? c : mine; }
        if (sum == G) break;
        __builtin_amdgcn_s_sleep(1);
        if ((++sp & 255u) == 0u) { if (xb_ld(&bar[XB_TMO])) break; if (sp > XB_SPIN_CAP) { atomicAdd(&bar[XB_TMO], 1u); break; } }
    }
    nloc = mine > 0u ? mine : 1u; nx = cnt > 0u ? cnt : 1u;
}

__device__ __forceinline__ void xcd_barrier(const XcdBarrier& b) {
    asm volatile("s_waitcnt vmcnt(0)" ::: "memory");
    __syncthreads();
    if (threadIdx.x == 0) {
        unsigned* bar = b.bar;
        __builtin_amdgcn_s_waitcnt(0);
        unsigned nloc = b.st[0], nx = b.st[1];
        if (nloc == 0u) { xcd_barrier_complete(bar, b.x, nloc, nx); b.st[0] = nloc; b.st[1] = nx; }
        const unsigned old = xb_add(&bar[XB_XSUB(b.x)], 1u);
        const unsigned gen = old / nloc;
        if (old + 1u == (gen + 1u) * nloc) {
            __builtin_amdgcn_fence(__ATOMIC_RELEASE, "agent");
            asm volatile("s_waitcnt vmcnt(0)" ::: "memory");
            const unsigned og = xb_add(&bar[XB_TOP], 1u);
            const unsigned tg = og / nx;
            if (og + 1u == (tg + 1u) * nx) xb_add(&bar[XB_TOPGEN], 1u);
            else XB_SPIN(xb_ld(&bar[XB_TOPGEN]) == tg, bar);
            __builtin_amdgcn_fence(__ATOMIC_ACQUIRE, "agent");
            xb_add(&bar[XB_XGEN(b.x)], 1u);
            asm volatile("s_waitcnt vmcnt(0)" ::: "memory");
        } else {
            XB_SPIN(xb_ld(&bar[XB_XGEN(b.x)]) == gen, bar);
            __builtin_amdgcn_fence(__ATOMIC_ACQUIRE, "agent");
            asm volatile("s_waitcnt vmcnt(0)" ::: "memory");
        }
    }
    __syncthreads();
}


namespace pg8 {
typedef int i32x4 __attribute__((ext_vector_type(4)));
template <bool I8> struct AccSel { typedef f32x4 T; };
template <> struct AccSel<true> { typedef i32x4 T; };
constexpr int BM = 256, BK = 64, HALF = 128, HTB = HALF * BK * 2, STAGE_BYTES = 8 * HTB, NXCD = 8, WGM = 8;
__device__ __forceinline__ int lds_byte(int r, int c) { const int st = (r >> 4) * 2 + (c >> 5), rr = r & 15, cc = c & 31, ob = rr * 64 + cc * 2; return st * 1024 + (ob ^ (((ob >> 9) & 1) << 5)); }
__device__ __forceinline__ void stage_rc(int b, int& R, int& C) { const int st = b / 1024, sb = b % 1024, swz = sb ^ (((sb >> 9) & 1) << 5); R = (st >> 1) * 16 + swz / 64; C = (st & 1) * 32 + (swz % 64) / 2; }
__device__ __forceinline__ int perm32(int rho) { const int n = rho >> 4, i = rho & 15; return 8 * (i >> 2) + 4 * n + (i & 3); }

struct Unit { int pm, pn; };

struct StaticOrder {
    int nM, nN, nwg, G, c;
    __device__ void init(int nM_, int nN_, int G_, int c_) { nM = nM_; nN = nN_; nwg = nM * nN; G = G_; c = c_; }
    __device__ bool next(int i, Unit& u) const {
        const long L = (long)i * G + c; if (L >= nwg) return false;
        int wgid = (int)L; { const int q = nwg / NXCD, r = nwg % NXCD, xcd = wgid % NXCD, off = wgid / NXCD; wgid = (xcd < r ? xcd * (q + 1) : r * (q + 1) + (xcd - r) * q) + off; }
        const int nig = WGM * nN, gid = wgid / nig, fm = gid * WGM, gsz = (nM - fm) < WGM ? (nM - fm) : WGM;
        u.pm = fm + ((wgid % nig) % gsz); u.pn = (wgid % nig) / gsz; return true;
    }
};
struct MoeOrder {
    StaticOrder so; const int* tbase; int nNt;
    __device__ void init(const int* tb, int nNt_, int G_, int c_) { tbase = tb; nNt = nNt_; so.init(tb[8], nNt_, G_, c_); }
    __device__ bool next(int i, Unit& u) const {
        if (!so.next(i, u)) return false;
        int e = 0;
#pragma unroll
        for (int j = 1; j < 8; ++j) e += (u.pm >= tbase[j]) ? 1 : 0;
        u.pn += e * nNt; return true;
    }
};

struct EpiBf16 {
    bf16* O; int ldc; int tps; size_t split_stride;
    __device__ __forceinline__ void operator()(const f32x4 (&acc)[2][2][4][2], const Unit& u, int wr, int wc, int fr, int fq) const {
        const int row0 = u.pm * BM + wr * 64 + fr; const int t = u.pn / tps; bf16* base = O + (size_t)t * split_stride;
        const int col0 = (u.pn - t * tps) * BM + wc * 32 + 8 * fq;
#pragma unroll
        for (int ai = 0; ai < 2; ++ai)
#pragma unroll
            for (int m = 0; m < 4; ++m) { bf16* rowp = base + (size_t)(row0 + ai * HALF + m * 16) * ldc + col0;
#pragma unroll
                for (int bj = 0; bj < 2; ++bj) { const f32x4 v0 = acc[ai][bj][m][0], v1 = acc[ai][bj][m][1];
                    u32x4 w; w.x = pk2(v0[0], v0[1]); w.y = pk2(v0[2], v0[3]); w.z = pk2(v1[0], v1[1]); w.w = pk2(v1[2], v1[3]);
                    *(u32x4*)(rowp + bj * HALF) = w; } }
    }
};
struct EpiSwiGLU {
    bf16* O; int ldc; int nNt;
    __device__ __forceinline__ void operator()(const f32x4 (&acc)[2][2][4][2], const Unit& u, int wr, int wc, int fr, int fq) const {
        const int row0 = u.pm * BM + wr * 64 + fr; const int col0 = (u.pn % nNt) * HALF + wc * 32 + 8 * fq;
#pragma unroll
        for (int ai = 0; ai < 2; ++ai)
#pragma unroll
            for (int m = 0; m < 4; ++m) { bf16* rowp = O + (size_t)(row0 + ai * HALF + m * 16) * ldc + col0;
                float r[8];
#pragma unroll
                for (int n = 0; n < 2; ++n)
#pragma unroll
                    for (int j = 0; j < 4; ++j) { const float g = acc[ai][0][m][n][j], up = acc[ai][1][m][n][j]; r[n * 4 + j] = siluf(g) * up; }
                u32x4 w; w.x = pk2(r[0], r[1]); w.y = pk2(r[2], r[3]); w.z = pk2(r[4], r[5]); w.w = pk2(r[6], r[7]);
                *(u32x4*)rowp = w; }
    }
};
struct EpiZQ {
    bf16* O; int ldc; int tps; size_t split_stride; const float* rs; float inv_w;
    __device__ __forceinline__ void operator()(const i32x4 (&acc)[2][2][4][2], const Unit& u, int wr, int wc, int fr, int fq) const {
        const int row0 = u.pm * BM + wr * 64 + fr; const int t = u.pn / tps; bf16* base = O + (size_t)t * split_stride;
        const int col0 = (u.pn - t * tps) * BM + wc * 32 + 8 * fq;
        float rsv[2][4];
#pragma unroll
        for (int ai = 0; ai < 2; ++ai)
#pragma unroll
            for (int m = 0; m < 4; ++m) rsv[ai][m] = rs[row0 + ai * HALF + m * 16];
#pragma unroll
        for (int ai = 0; ai < 2; ++ai)
#pragma unroll
            for (int m = 0; m < 4; ++m) { const int r = row0 + ai * HALF + m * 16; bf16* rowp = base + (size_t)r * ldc + col0; const float s = rsv[ai][m] * inv_w;
#pragma unroll
                for (int bj = 0; bj < 2; ++bj) { const f32x4 v0 = __builtin_convertvector(acc[ai][bj][m][0], f32x4) * s, v1 = __builtin_convertvector(acc[ai][bj][m][1], f32x4) * s;
                    u32x4 w; w.x = pk2(v0[0], v0[1]); w.y = pk2(v0[2], v0[3]); w.z = pk2(v1[0], v1[1]); w.w = pk2(v1[2], v1[3]);
                    *(u32x4*)(rowp + bj * HALF) = w; } }
    }
};
struct EpiSwiGLUQ {
    unsigned char* O; int ldc; int nNt; const float* rs; float inv_w, s_out;
    __device__ __forceinline__ void operator()(const i32x4 (&acc)[2][2][4][2], const Unit& u, int wr, int wc, int fr, int fq) const {
        const int row0 = u.pm * BM + wr * 64 + fr; const int col0 = (u.pn % nNt) * HALF + wc * 32 + 8 * fq;
        float rsv[2][4];
#pragma unroll
        for (int ai = 0; ai < 2; ++ai)
#pragma unroll
            for (int m = 0; m < 4; ++m) rsv[ai][m] = rs[row0 + ai * HALF + m * 16];
#pragma unroll
        for (int ai = 0; ai < 2; ++ai)
#pragma unroll
            for (int m = 0; m < 4; ++m) { unsigned char* rowp = O + (size_t)(row0 + ai * HALF + m * 16) * ldc + col0; const float inv_in = rsv[ai][m] * inv_w;
                const float c1 = inv_in * -1.44269504f, c2 = inv_in * inv_in * s_out;
                float r[8];
#pragma unroll
                for (int n = 0; n < 2; ++n)
#pragma unroll
                    for (int j = 0; j < 4; ++j) { const float fg = (float)acc[ai][0][m][n][j], fu = (float)acc[ai][1][m][n][j];
                        r[n * 4 + j] = (fg * fu) * c2 * __builtin_amdgcn_rcpf(1.0f + __builtin_amdgcn_exp2f(fg * c1)); }
                u32x2 w; w.x = pk4_i8(r[0], r[1], r[2], r[3]); w.y = pk4_i8(r[4], r[5], r[6], r[7]);
                *(u32x2*)rowp = w; }
    }
};
struct EpiResid {
    unsigned char* ws; const float* in0_ctx; const float* in0_lat; const float* gate; int row_off; float sc; const float* rs;
    template <class AT> __device__ __forceinline__ void operator()(const AT (&acc)[2][2][4][2], const Unit& u, int wr, int wc, int fr, int fq) const {
        const int grow0 = row_off + u.pm * BM; const bool isctx = grow0 < NCTX; const int b = isctx ? 8 : ((grow0 - NCTX) >> 13);
        bf16* hb = isctx ? (bf16*)(ws + WS_HCTX) + (size_t)grow0 * D : hlat_row(ws, grow0 - NCTX);
        const float* hin = isctx ? in0_ctx + (size_t)grow0 * D : in0_lat + (size_t)(grow0 - NCTX) * D;
        const bool first = in0_lat != nullptr;
        const int col0 = u.pn * BM + wc * 32 + 8 * fq;
        f32x4 gv[2][2];
#pragma unroll
        for (int bj = 0; bj < 2; ++bj)
#pragma unroll
            for (int n = 0; n < 2; ++n) gv[bj][n] = *(const f32x4*)(gate + (size_t)b * 6144 + col0 + bj * HALF + 4 * n) * sc;
        float rsa[2][4];
#pragma unroll
        for (int ai = 0; ai < 2; ++ai)
#pragma unroll
            for (int m = 0; m < 4; ++m) rsa[ai][m] = rs ? rs[grow0 + wr * 64 + fr + ai * HALF + m * 16] : 1.0f;
#pragma unroll
        for (int ai = 0; ai < 2; ++ai)
#pragma unroll
            for (int m = 0; m < 4; ++m) { const int rl = wr * 64 + fr + ai * HALF + m * 16; const size_t ro = (size_t)rl * D + col0; const float rsv = rsa[ai][m];
#pragma unroll
                for (int bj = 0; bj < 2; ++bj) { f32x4 h0, h1;
                    if (first) { h0 = *(const f32x4*)(hin + ro + bj * HALF); h1 = *(const f32x4*)(hin + ro + bj * HALF + 4); }
                    else { const u32x4 hw = *(const u32x4*)(hb + ro + bj * HALF); h0 = (f32x4){bflo(hw.x), bfhi(hw.x), bflo(hw.y), bfhi(hw.y)}; h1 = (f32x4){bflo(hw.z), bfhi(hw.z), bflo(hw.w), bfhi(hw.w)}; }
                    h0 += gv[bj][0] * (__builtin_convertvector(acc[ai][bj][m][0], f32x4) * rsv); h1 += gv[bj][1] * (__builtin_convertvector(acc[ai][bj][m][1], f32x4) * rsv);
                    u32x4 w; w.x = pk2(h0[0], h0[1]); w.y = pk2(h0[2], h0[3]); w.z = pk2(h1[0], h1[1]); w.w = pk2(h1[2], h1[3]);
                    *(u32x4*)(hb + ro + bj * HALF) = w; } }
    }
};
struct EpiScatter {
    bf16* YB; const int* list; int nNt; float sc;
    template <class AT> __device__ __forceinline__ void operator()(const AT (&acc)[2][2][4][2], const Unit& u, int wr, int wc, int fr, int fq) const {
        const int row0 = u.pm * BM + wr * 64 + fr; const int col0 = (u.pn % nNt) * BM + wc * 32 + 8 * fq;
#pragma unroll
        for (int ai = 0; ai < 2; ++ai)
#pragma unroll
            for (int m = 0; m < 4; ++m) { const int ent = list[row0 + ai * HALF + m * 16];
                if (ent >= 0) { bf16* rowp = YB + ((size_t)(ent & 1) * NTOK + (size_t)(ent >> 1)) * D + col0;
#pragma unroll
                    for (int bj = 0; bj < 2; ++bj) { const f32x4 v0 = __builtin_convertvector(acc[ai][bj][m][0], f32x4) * sc, v1 = __builtin_convertvector(acc[ai][bj][m][1], f32x4) * sc;
                        u32x4 w; w.x = pk2(v0[0], v0[1]); w.y = pk2(v0[2], v0[3]); w.z = pk2(v1[0], v1[1]); w.w = pk2(v1[2], v1[3]);
                        *(u32x4*)(rowp + bj * HALF) = w; } }
                asm volatile("" ::: "memory"); }
    }
};

template <class Epi, class Sched, bool GATHER, bool I8 = false>
__device__ __forceinline__ void gemm_phase(LAS unsigned char* lds, const bf16* A, const bf16* Bt, const int K, const Sched& S, const Epi& E, const int* glist) {
    int tid_ = threadIdx.x; asm volatile("" : "+v"(tid_));
    const int tid = tid_, wid = __builtin_amdgcn_readfirstlane(tid >> 6), lane = tid & 63, wr = wid >> 2, wc = wid & 3, fr = lane & 15, fq = lane >> 4;
    const int nt = K / BK;
    int RA0, CA0; stage_rc(tid * 16, RA0, CA0);
    const unsigned voffA0 = (unsigned)(RA0 * K + CA0) * 2u, voffB0 = (unsigned)(((RA0 & ~31) + perm32(RA0 & 31)) * K + CA0) * 2u;
    const unsigned pstep = 64u * (unsigned)K * 2u, kstep = (unsigned)BK * 2u, hstep = (unsigned)HALF * (unsigned)K * 2u, tstep = 2u * hstep;
    const unsigned ldsw = (unsigned)wid * 1024u;
    const int aoff = lds_byte(wr * 64 + fr, fq * 8), boff = lds_byte(wc * 32 + fr, fq * 8);
    unsigned gA[2][2];
#define PG8_GOFF(dst, u) do { _Pragma("unroll") for (int _h = 0; _h < 2; ++_h) _Pragma("unroll") for (int _i = 0; _i < 2; ++_i) { \
        const int _e = glist[(u).pm * BM + _h * HALF + _i * 64 + RA0]; const int _r = _e < 0 ? 0 : (_e >> 1); dst[_h][_i] = (unsigned)(_r * K + CA0) * 2u; } } while (0)
#define PG8_SA(b, h) (((b) * 2 + (h)) * HTB)
#define PG8_SB(b, h) ((4 + (b) * 2 + (h)) * HTB)
#define PG8_LD(ldsoff, base, off32) __builtin_amdgcn_global_load_lds((const unsigned*)((const char*)(base) + (size_t)(unsigned)(off32)), (LAS unsigned*)(lds + (ldsoff) + ldsw), 16, 0, 0)
#define PG8_STAGE_B(bufoff, soff) do { _Pragma("unroll") for (int _i = 0; _i < 2; ++_i) PG8_LD((bufoff) + _i * 8192, Bt, voffB0 + ((soff) + _i * pstep)); } while (0)
#define PG8_STAGE_A(bufoff, soff, kb, h, nx) do { if constexpr (GATHER) { _Pragma("unroll") for (int _i = 0; _i < 2; ++_i) PG8_LD((bufoff) + _i * 8192, A, gA[h][_i] + (kb)); } \
        else { _Pragma("unroll") for (int _i = 0; _i < 2; ++_i) PG8_LD((bufoff) + _i * 8192, A, voffA0 + ((soff) + (kb) + (h) * hstep + _i * pstep)); } } while (0)
#define PG8_LDA(dst, b, h) do { _Pragma("unroll") for (int m = 0; m < 4; ++m) _Pragma("unroll") for (int k = 0; k < 2; ++k) dst[m][k] = *(const LAS bf16x8*)(lds + PG8_SA(b, h) + aoff + m * 2048 + k * 1024); } while (0)
#define PG8_LDB(dst, b, h) do { _Pragma("unroll") for (int n = 0; n < 2; ++n) _Pragma("unroll") for (int k = 0; k < 2; ++k) dst[n][k] = *(const LAS bf16x8*)(lds + PG8_SB(b, h) + boff + n * 2048 + k * 1024); } while (0)
#define PG8_MMA(ai, bj, At, Bt_) do { __builtin_amdgcn_s_setprio(1); _Pragma("unroll") for (int m = 0; m < 4; ++m) _Pragma("unroll") for (int n = 0; n < 2; ++n) _Pragma("unroll") for (int k = 0; k < 2; ++k) { \
            if constexpr (I8) acc[ai][bj][m][n] = __builtin_amdgcn_mfma_i32_16x16x64_i8(__builtin_bit_cast(i32x4, Bt_[n][k]), __builtin_bit_cast(i32x4, At[m][k]), acc[ai][bj][m][n], 0, 0, 0); \
            else acc[ai][bj][m][n] = __builtin_amdgcn_mfma_f32_16x16x32_bf16(Bt_[n][k], At[m][k], acc[ai][bj][m][n], 0, 0, 0); } \
        __builtin_amdgcn_s_setprio(0); } while (0)
#define PG8_WAIT_V(n) asm volatile("s_waitcnt vmcnt(" #n ")" ::: "memory")
#define PG8_WAIT_L(n) asm volatile("s_waitcnt lgkmcnt(" #n ")" ::: "memory")
#define PG8_BAR __builtin_amdgcn_s_barrier()
#define PG8_SCHED __builtin_amdgcn_sched_barrier(0)
    Unit cur, nxt; int ui = 0;
    if (!S.next(0, cur)) return;
    typedef typename AccSel<I8>::T AccT;
    AccT acc[2][2][4][2];
#pragma unroll
    for (int a = 0; a < 2; ++a)
#pragma unroll
        for (int b = 0; b < 2; ++b)
#pragma unroll
            for (int m = 0; m < 4; ++m)
#pragma unroll
                for (int n = 0; n < 2; ++n) acc[a][b][m][n] = (AccT){0, 0, 0, 0};
    bf16x8 At[4][2], B0[2][2], B1[2][2];

    unsigned uA = GATHER ? 0u : (unsigned)cur.pm * tstep, uB = (unsigned)cur.pn * tstep;
    if constexpr (GATHER) { PG8_GOFF(gA, cur); }
    PG8_STAGE_B(PG8_SB(0, 0), uB); PG8_STAGE_B(PG8_SB(0, 1), uB + hstep); PG8_STAGE_A(PG8_SA(0, 0), uA, 0u, 0, false); PG8_STAGE_A(PG8_SA(0, 1), uA, 0u, 1, false);
    if (wr == 1) PG8_BAR;
    PG8_WAIT_V(2); PG8_BAR;
    PG8_STAGE_B(PG8_SB(1, 0), uB + kstep); PG8_STAGE_A(PG8_SA(1, 0), uA, kstep, 0, false); PG8_STAGE_B(PG8_SB(1, 1), uB + hstep + kstep);
    PG8_WAIT_V(6); PG8_BAR;
    for (;;) {
        const bool has_next = S.next(ui + 1, nxt);
        const unsigned nuA = (has_next && !GATHER) ? (unsigned)nxt.pm * tstep : uA, nuB = has_next ? (unsigned)nxt.pn * tstep : uB;
        _Pragma("nounroll") for (int t = 0; t < nt; t += 2) {
            const bool last = (t == nt - 2);
            const unsigned k1 = (unsigned)(t + 1) * kstep, k2 = last ? 0u : (unsigned)(t + 2) * kstep, k3 = k2 + kstep;
            const unsigned a2 = last ? nuA : uA, b2 = (last ? nuB : uB) + k2, b3 = b2 + kstep;
            unsigned gN[2][2];
            if constexpr (GATHER) { if (last && has_next) { PG8_GOFF(gN, nxt); } else {
#pragma unroll
                for (int _h = 0; _h < 2; ++_h)
#pragma unroll
                    for (int _i = 0; _i < 2; ++_i) gN[_h][_i] = gA[_h][_i]; } }
            PG8_LDB(B0, 0, 0); PG8_LDB(B1, 0, 1); PG8_SCHED; PG8_LDA(At, 0, 0); PG8_STAGE_A(PG8_SA(1, 1), uA, k1, 1, false);
            PG8_WAIT_V(8); PG8_WAIT_L(0); PG8_BAR; PG8_MMA(0, 0, At, B0); PG8_MMA(0, 1, At, B1); PG8_BAR; PG8_SCHED;
            if constexpr (GATHER) {
#pragma unroll
                for (int _h = 0; _h < 2; ++_h)
#pragma unroll
                    for (int _i = 0; _i < 2; ++_i) gA[_h][_i] = gN[_h][_i]; }
            PG8_LDA(At, 0, 1); PG8_STAGE_B(PG8_SB(0, 0), b2); PG8_STAGE_B(PG8_SB(0, 1), b2 + hstep); PG8_STAGE_A(PG8_SA(0, 0), a2, k2, 0, last);
            PG8_WAIT_V(8); PG8_WAIT_L(0); PG8_BAR; PG8_MMA(1, 0, At, B0); PG8_MMA(1, 1, At, B1); PG8_BAR; PG8_SCHED;
            PG8_LDB(B0, 1, 0); PG8_LDB(B1, 1, 1); PG8_SCHED; PG8_LDA(At, 1, 0); PG8_STAGE_A(PG8_SA(0, 1), a2, k2, 1, last);
            PG8_WAIT_V(8); PG8_WAIT_L(0); PG8_BAR; PG8_MMA(0, 0, At, B0); PG8_MMA(0, 1, At, B1); PG8_BAR; PG8_SCHED;
            PG8_LDA(At, 1, 1); PG8_STAGE_B(PG8_SB(1, 0), b3); PG8_STAGE_B(PG8_SB(1, 1), b3 + hstep); PG8_STAGE_A(PG8_SA(1, 0), a2, k3, 0, last);
            PG8_WAIT_V(8); PG8_WAIT_L(0); PG8_BAR; PG8_MMA(1, 0, At, B0); PG8_MMA(1, 1, At, B1); PG8_BAR; PG8_SCHED;
        }
        if (wr == 0) PG8_BAR;
        E(acc, cur, wr, wc, fr, fq);
        if (!has_next) break;
#pragma unroll
        for (int a = 0; a < 2; ++a)
#pragma unroll
            for (int b = 0; b < 2; ++b)
#pragma unroll
                for (int m = 0; m < 4; ++m)
#pragma unroll
                    for (int n = 0; n < 2; ++n) acc[a][b][m][n] = (AccT){0, 0, 0, 0};
        cur = nxt; uA = nuA; uB = nuB; ++ui;
        if (wr == 1) PG8_BAR;
    }
    PG8_WAIT_V(0);
    PG8_BAR;
#undef PG8_GOFF
#undef PG8_SA
#undef PG8_SB
#undef PG8_LD
#undef PG8_STAGE_B
#undef PG8_STAGE_A
#undef PG8_LDA
#undef PG8_LDB
#undef PG8_MMA
#undef PG8_WAIT_V
#undef PG8_WAIT_L
#undef PG8_BAR
#undef PG8_SCHED
}
}

struct Args { const float* in[21]; float* out; unsigned char* ws; int ph_lo, ph_hi, dbl, pad; };
enum { IN_X = 0, IN_C, IN_CTX, IN_CCTX, IN_WADA, IN_BADA, IN_NORMW, IN_WIN, IN_LBRAW, IN_HNORMW, IN_WPOOL, IN_PSCALE, IN_WOUT, IN_FWG, IN_FWU, IN_FWD, IN_ROUTER, IN_MWG, IN_MWU, IN_MWD, IN_FNW };

struct Frame {
    const Args* a; unsigned char* ws; LAS unsigned char* lds; int tid, lane, wid, G, bid;
};
#define PH_LOCALS(F) int tid = (F).tid; asm volatile("" : "+v"(tid)); const int lane = tid & 63; const int wid = __builtin_amdgcn_readfirstlane(tid >> 6); unsigned char* ws = (F).ws; (void)lane; (void)wid; (void)ws;

#define GAS __attribute__((address_space(1)))
struct WJob { const GAS float* src; bf16* dst; unsigned ld, dld; int k0, n0, drow0, gstride; float qs; };
constexpr int WT_DENSE = 1952, WT_MOE = 5376;
__device__ __forceinline__ WJob wjob(const Args& a, unsigned char* ws, int kind, int mi, int t) {
    WJob j; j.qs = 0.f;
    if (kind == 0) {
        if (t < 896) { const int l = t / 224, r = t % 224;
            if (r < 160) { const int piece = r / 32, q = r % 32, kt = q >> 1, ntile = q & 1;
                const int sc0 = piece == 0 ? 0 : piece == 1 ? 1024 : piece == 2 ? 1536 : piece == 3 ? 512 : 2048;
                j.src = (const GAS float*)a.in[IN_WIN] + (size_t)l * 1024 * 3072; j.ld = 3072; j.k0 = kt * 64; j.n0 = sc0 + ntile * 256;
                j.dst = (bf16*)(ws + WS_WIN + (size_t)l * 3072 * 1024); j.dld = 1024; j.drow0 = piece * 512 + ntile * 256; j.gstride = 128; j.qs = Q_SW1; }
            else { const int q = r - 160, kt = q >> 2, ntile = q & 3;
                j.src = (const GAS float*)a.in[IN_WOUT] + (size_t)l * 1024 * 1024; j.ld = 1024; j.k0 = kt * 64; j.n0 = ntile * 256;
                j.dst = (bf16*)(ws + WS_WOUT + (size_t)l * 1024 * 1024); j.dld = 1024; j.drow0 = j.n0; j.gstride = 128; j.qs = Q_SW1; } }
        else { const int t2 = t - 896, i = t2 / 528, r = t2 % 528;
            if (r < 352) { const int up = r / 176, q = r % 176, kt = q / 11, ntile = q % 11;
                j.src = (const GAS float*)(up ? a.in[IN_FWU] : a.in[IN_FWG]) + (size_t)i * 1024 * DFF; j.ld = DFF; j.k0 = kt * 64; j.n0 = ntile * 256;
                j.dst = (bf16*)(ws + WS_WF1 + (size_t)i * 5632 * 1024); j.dld = 1024; j.drow0 = ntile * 512 + up * 128; j.gstride = 256; j.qs = Q_SW1; }
            else { const int q = r - 352, kt = q >> 2, ntile = q & 3;
                j.src = (const GAS float*)a.in[IN_FWD] + (size_t)i * DFF * 1024; j.ld = 1024; j.k0 = kt * 64; j.n0 = ntile * 256;
                j.dst = (bf16*)(ws + WS_WF2 + (size_t)i * 1024 * DFF); j.dld = DFF; j.drow0 = j.n0; j.gstride = 128; j.qs = Q_SW2D; } }
    } else {
        const int e = t / 672, r = t % 672; const size_t eo = (size_t)(mi * 8 + e) * 1024 * DFE;
        const float* pwg = a.in[IN_MWG]; const float* pwu = a.in[IN_MWU]; const float* pwd = a.in[IN_MWD];
        asm volatile("" : "+s"(pwg)); asm volatile("" : "+s"(pwu)); asm volatile("" : "+s"(pwd));
        if (r < 448) { const int up = r / 224, q = r % 224, kt = q / 14, ntile = q % 14;
            j.src = (const GAS float*)(up ? pwu : pwg) + eo; j.ld = DFE; j.k0 = kt * 64; j.n0 = ntile * 256;
            j.dst = (bf16*)(ws + WS_WM1 + (size_t)e * 7168 * 1024); j.dld = 1024; j.drow0 = ntile * 512 + up * 128; j.gstride = 256; j.qs = Q_SW1; }
        else { const int q = r - 448, kt = q >> 2, ntile = q & 3;
            j.src = (const GAS float*)pwd + eo; j.ld = 1024; j.k0 = kt * 64; j.n0 = ntile * 256;
            j.dst = (bf16*)(ws + WS_WM2 + (size_t)e * 1024 * DFE); j.dld = DFE; j.drow0 = j.n0; j.gstride = 128; j.qs = Q_SW2; }
    }
    return j;
}
__device__ __forceinline__ void wprep_run(const Frame& F, int kind, int mi, int t0, int ntiles, int wk, int nwk) {
    const Args& a = *F.a; PH_LOCALS(F)
    if (wk < 0) return;
    LAS bf16* Tt = (LAS bf16*)F.lds;
    const int kg = tid >> 6, c4 = (tid & 63) * 4;
    f32x4 v[8];
#pragma unroll
    for (int i = 0; i < 8; ++i) v[i] = (f32x4){0.f, 0.f, 0.f, 0.f};
    const int tf = t0 + wk;
    WJob j = wjob(a, ws, kind, mi, tf < ntiles ? tf : t0);
    if (tf < ntiles) {
#pragma unroll
        for (int i = 0; i < 8; ++i) v[i] = *(const GAS f32x4*)(j.src + (size_t)(j.k0 + kg * 8 + i) * j.ld + j.n0 + c4); }
    for (int t = tf; t < ntiles; t += nwk) {
        if (j.qs != 0.f) {
            LAS unsigned char* T8 = (LAS unsigned char*)F.lds;
            const float qs = j.qs;
#pragma unroll
            for (int e = 0; e < 4; ++e) { u32x2 w; w.x = pk4_i8(v[0][e] * qs, v[1][e] * qs, v[2][e] * qs, v[3][e] * qs); w.y = pk4_i8(v[4][e] * qs, v[5][e] * qs, v[6][e] * qs, v[7][e] * qs);
                *(LAS u32x2*)(T8 + (c4 + e) * 72 + kg * 8) = w; }
            __syncthreads();
            const WJob jc = j;
            if (t + nwk < ntiles) { j = wjob(a, ws, kind, mi, t + nwk);
#pragma unroll
                for (int i = 0; i < 8; ++i) v[i] = *(const GAS f32x4*)(j.src + (size_t)(j.k0 + kg * 8 + i) * j.ld + j.n0 + c4); }
            const int n = tid >> 1, kh = tid & 1;
            u32x2 r[4];
#pragma unroll
            for (int q = 0; q < 4; ++q) r[q] = *(const LAS u32x2*)(T8 + n * 72 + kh * 32 + q * 8);
            u32x4* dp = (u32x4*)((unsigned char*)jc.dst + (size_t)(jc.drow0 + (n >> 7) * jc.gstride + (n & 127)) * jc.dld + jc.k0 + kh * 32);
            dp[0] = (u32x4){r[0].x, r[0].y, r[1].x, r[1].y}; dp[1] = (u32x4){r[2].x, r[2].y, r[3].x, r[3].y};
            __syncthreads();
            continue;
        }
#pragma unroll
        for (int e = 0; e < 4; ++e) { u32x4 w; w.x = pk2(v[0][e], v[1][e]); w.y = pk2(v[2][e], v[3][e]); w.z = pk2(v[4][e], v[5][e]); w.w = pk2(v[6][e], v[7][e]);
            *(LAS u32x4*)(Tt + (c4 + e) * 72 + kg * 8) = w; }
        __syncthreads();
        const WJob jc = j;
        if (t + nwk < ntiles) { j = wjob(a, ws, kind, mi, t + nwk);
#pragma unroll
            for (int i = 0; i < 8; ++i) v[i] = *(const GAS f32x4*)(j.src + (size_t)(j.k0 + kg * 8 + i) * j.ld + j.n0 + c4); }
        const int n = tid >> 1, kh = tid & 1;
        u32x4 r[4];
#pragma unroll
        for (int q = 0; q < 4; ++q) r[q] = *(const LAS u32x4*)(Tt + n * 72 + kh * 32 + q * 8);
        u32x4* dp = (u32x4*)(jc.dst + (size_t)(jc.drow0 + (n >> 7) * jc.gstride + (n & 127)) * jc.dld + jc.k0 + kh * 32);
#pragma unroll
        for (int q = 0; q < 4; ++q) dp[q] = r[q];
        __syncthreads();
    }
}

__device__ __forceinline__ void ph_prologue(const Frame& F) {
    const Args& a = *F.a; PH_LOCALS(F)
    {
        LAS float* sl = (LAS float*)F.lds;
        LAS float* red = sl + 9 * 1024;
        for (int i = tid; i < 9 * 1024; i += NTHR) { const int r = i >> 10, k = i & 1023; const float v = r < 8 ? a.in[IN_C][r * 1024 + k] : a.in[IN_CCTX][k]; sl[i] = siluf(v); }
        __syncthreads();
        float* mods = (float*)(ws + WS_MODS);
        for (int u = F.bid; u < 4 * 96; u += F.G) {
            const int l = u / 96, cb = u % 96, cc = tid & 63, ks = tid >> 6;
            const float* w = a.in[IN_WADA] + (size_t)l * 1024 * 6144 + cb * 64 + cc;
            float acc[9];
#pragma unroll
            for (int r = 0; r < 9; ++r) acc[r] = 0.f;
            for (int k = ks * 128; k < ks * 128 + 128; ++k) { const float wv = w[(size_t)k * 6144];
#pragma unroll
                for (int r = 0; r < 9; ++r) acc[r] += sl[r * 1024 + k] * wv; }
#pragma unroll
            for (int r = 0; r < 9; ++r) red[(ks * 64 + cc) * 9 + r] = acc[r];
            __syncthreads();
            for (int i = tid; i < 64 * 9; i += NTHR) { const int c2 = i / 9, r = i % 9; float s = 0.f;
#pragma unroll
                for (int k2 = 0; k2 < 8; ++k2) s += red[(k2 * 64 + c2) * 9 + r];
                mods[(size_t)(l * 9 + r) * 6144 + cb * 64 + c2] = s + a.in[IN_BADA][l * 6144 + cb * 64 + c2]; }
            __syncthreads();
        }
    }
    if (F.bid == 0) {
        float* lb = (float*)(ws + WS_LB);
        for (int i = tid; i < 1024; i += NTHR) {
            const float r0 = a.in[IN_LBRAW][i], r1 = a.in[IN_LBRAW][1024 + i], r2 = a.in[IN_LBRAW][2048 + i], r3 = a.in[IN_LBRAW][3072 + i];
            const float m = fmaxf(fmaxf(r0, r1), fmaxf(r2, r3));
            const float e0 = __expf(r0 - m), e1 = __expf(r1 - m), e2 = __expf(r2 - m), e3 = __expf(r3 - m);
            const float inv = 1.0f / (e0 + e1 + e2 + e3);
            lb[i] = 0.f; lb[1024 + i] = e1 * inv; lb[2048 + i] = (e1 + e2) * inv; lb[3072 + i] = (e1 + e2 + e3) * inv;
        }
    }
    wprep_run(F, 0, 0, 0, WT_DENSE, F.bid, F.G);
    {
        LAS float* Wt = (LAS float*)F.lds;
        LAS float* Wp = Wt + 64 * 128;
        for (int u = F.bid; u < 256; u += F.G) {
            const int l = u >> 6, j = (u >> 4) & 3, kb = u & 15, k0 = kb * 64;
            const float* wi = a.in[IN_WIN] + (size_t)l * 1024 * 3072 + 2560 + j * 128;
            const float* wp = a.in[IN_WPOOL] + (size_t)(l * 4 + j) * 128 * 128;
            for (int i = tid; i < 64 * 32; i += NTHR) { const int k = i >> 5, c4 = (i & 31) * 4; *(LAS f32x4*)(Wt + k * 128 + c4) = *(const f32x4*)(wi + (size_t)(k0 + k) * 3072 + c4); }
            for (int i = tid; i < 128 * 32; i += NTHR) *(LAS f32x4*)(Wp + i * 4) = *(const f32x4*)(wp + i * 4);
            __syncthreads();
            const int k = tid >> 3, d0 = (tid & 7) * 16;
            float acc[16];
#pragma unroll
            for (int e = 0; e < 16; ++e) acc[e] = 0.f;
            for (int c = 0; c < 128; ++c) { const float av = Wt[k * 128 + c];
#pragma unroll
                for (int e4 = 0; e4 < 4; ++e4) { const f32x4 wv = *(const LAS f32x4*)(Wp + c * 128 + d0 + e4 * 4);
                    acc[e4 * 4 + 0] += av * wv[0]; acc[e4 * 4 + 1] += av * wv[1]; acc[e4 * 4 + 2] += av * wv[2]; acc[e4 * 4 + 3] += av * wv[3]; } }
            signed char* dst = (signed char*)(ws + WS_WIN + (size_t)l * 3072 * 1024);
#pragma unroll
            for (int e = 0; e < 16; ++e) { const int dcol = j * 128 + d0 + e; dst[(size_t)(2560 + dcol) * 1024 + k0 + k] = (signed char)(int)__builtin_rintf(fminf(fmaxf(acc[e] * Q_SW1, -127.f), 127.f)); }
            __syncthreads();
        }
    }
}

template <int WHICH>
__device__ __forceinline__ void ph_norm(const Frame& F, int l) {
    const Args& a = *F.a; PH_LOCALS(F)
    const bool router = (WHICH == 1) && (l & 1);
    LAS float* RW = (LAS float*)F.lds;
    if (router) { const float* rw = a.in[IN_ROUTER] + (size_t)(l >> 1) * 1024 * 8;
        for (int s_ = tid; s_ < 2048; s_ += NTHR) { const int col_ = s_ >> 1, hf_ = s_ & 1, i_ = (col_ >> 9) * 2 + ((col_ >> 2) & 1), ln_ = (col_ & 511) >> 3, j_ = col_ & 3;
            *(LAS f32x4*)(RW + ((((i_ * 4 + j_) * 2 + hf_) * 64 + ln_) * 4)) = *(const f32x4*)(rw + s_ * 4); }
        __syncthreads(); }
    const int row_lo = (WHICH == 0 || (WHICH == 1 && l < 3)) ? 0 : NCTX, nrows = NTOK - row_lo;
    const int nw = F.G * 8, gw = F.bid * 8 + wid, per = (nrows + nw - 1) / nw;
    const int r0 = row_lo + gw * per, r1 = (r0 + per < NTOK) ? r0 + per : NTOK;
    const bool has_add = (WHICH == 2) || (WHICH == 0 && l > 0 && ((l - 1) & 1));
    const bool first = (l == 0) && (WHICH == 0);
    const bool add_moe = has_add;
    const int lg = (WHICH == 0 ? l - 1 : 3), gi = 5;
    const float* mods = (const float*)(ws + WS_MODS);
    const bf16* yb = (const bf16*)(ws + WS_YB);
    float* route = (float*)(ws + WS_ROUTE);
    bf16* uout = (bf16*)(ws + WS_R1);
    bf16* hctx = (bf16*)(ws + WS_HCTX);
    int curb = -1; f32x4 pa[4], psh[4], pg[4];
    int ecnt[8];
#pragma unroll
    for (int e = 0; e < 8; ++e) ecnt[e] = 0;
#pragma unroll
    for (int i = 0; i < 4; ++i) { pa[i] = (f32x4){0.f, 0.f, 0.f, 0.f}; psh[i] = pa[i]; pg[i] = pa[i]; }
#define NORM_SRCF(row_) ((row_) < NCTX ? a.in[IN_CTX] + (size_t)(row_) * D : a.in[IN_X] + (size_t)((row_) - NCTX) * D)
#define NORM_SRCB(row_) ((row_) < NCTX ? hctx + (size_t)(row_) * D : hlat_row(ws, (row_) - NCTX))
#define NCOL(i_) (((i_) >> 1) * 512 + lane * 8 + ((i_) & 1) * 4)
#define NORM_LOAD(dst_, row_) do { if (first) { const float* p_ = NORM_SRCF(row_); _Pragma("unroll") for (int i = 0; i < 4; ++i) dst_[i] = *(const f32x4*)(p_ + NCOL(i)); } \
        else { const bf16* p_ = NORM_SRCB(row_); _Pragma("unroll") for (int g = 0; g < 2; ++g) { const u32x4 w_ = *(const u32x4*)(p_ + g * 512 + lane * 8); dst_[2 * g] = (f32x4){bflo(w_.x), bfhi(w_.x), bflo(w_.y), bfhi(w_.y)}; dst_[2 * g + 1] = (f32x4){bflo(w_.z), bfhi(w_.z), bflo(w_.w), bfhi(w_.w)}; } } } while (0)
    f32x4 hn[4], hn2[4];
#pragma unroll
    for (int i = 0; i < 4; ++i) { hn[i] = (f32x4){0.f, 0.f, 0.f, 0.f}; hn2[i] = hn[i]; }
    if (r0 < r1) NORM_LOAD(hn, r0);
    if (r0 + 1 < r1) NORM_LOAD(hn2, r0 + 1);
    for (int row = r0; row < r1; ++row) {
        int b; bf16* hd; float* od = a.out;
        if (row < NCTX) { b = 8; hd = hctx + (size_t)row * D; }
        else { const int rr = row - NCTX; b = rr >> 13; hd = hlat_row(ws, rr); od = a.out + (size_t)rr * D; }
        if (b != curb) { curb = b;
#pragma unroll
            for (int i = 0; i < 4; ++i) { const int col = NCOL(i);
                if (WHICH < 2) { const f32x4 nwv = *(const f32x4*)(a.in[IN_NORMW] + l * 2048 + WHICH * 1024 + col);
                    const f32x4 sc = *(const f32x4*)(mods + (size_t)(l * 9 + b) * 6144 + (WHICH ? 4 : 1) * 1024 + col);
                    psh[i] = *(const f32x4*)(mods + (size_t)(l * 9 + b) * 6144 + (WHICH ? 3 : 0) * 1024 + col);
                    pa[i] = nwv * (sc + 1.0f); }
                else pa[i] = *(const f32x4*)(a.in[IN_FNW] + col);
                if (has_add) pg[i] = *(const f32x4*)(mods + (size_t)(lg * 9 + b) * 6144 + gi * 1024 + col); } }
        f32x4 h[4];
#pragma unroll
        for (int i = 0; i < 4; ++i) { h[i] = hn[i]; hn[i] = hn2[i]; }
        if (row + 2 < r1) NORM_LOAD(hn2, row + 2);
        if (has_add) {
            if (add_moe) { const float w0 = route[(size_t)row * 4 + 2], w1 = route[(size_t)row * 4 + 3];
#pragma unroll
                for (int g = 0; g < 2; ++g) { const u32x4 y0 = *(const u32x4*)(yb + (size_t)row * D + g * 512 + lane * 8), y1 = *(const u32x4*)(yb + ((size_t)NTOK + row) * D + g * 512 + lane * 8);
                    f32x4 y; y[0] = w0 * bflo(y0.x) + w1 * bflo(y1.x); y[1] = w0 * bfhi(y0.x) + w1 * bfhi(y1.x); y[2] = w0 * bflo(y0.y) + w1 * bflo(y1.y); y[3] = w0 * bfhi(y0.y) + w1 * bfhi(y1.y);
                    h[2 * g] += pg[2 * g] * y;
                    y[0] = w0 * bflo(y0.z) + w1 * bflo(y1.z); y[1] = w0 * bfhi(y0.z) + w1 * bfhi(y1.z); y[2] = w0 * bflo(y0.w) + w1 * bflo(y1.w); y[3] = w0 * bfhi(y0.w) + w1 * bfhi(y1.w);
                    h[2 * g + 1] += pg[2 * g + 1] * y; } }
            if (WHICH != 2) {
#pragma unroll
                for (int g = 0; g < 2; ++g) { u32x4 w; w.x = pk2(h[2 * g][0], h[2 * g][1]); w.y = pk2(h[2 * g][2], h[2 * g][3]); w.z = pk2(h[2 * g + 1][0], h[2 * g + 1][1]); w.w = pk2(h[2 * g + 1][2], h[2 * g + 1][3]); *(u32x4*)(hd + g * 512 + lane * 8) = w; } }
        }
        float ss = 0.f;
#pragma unroll
        for (int i = 0; i < 4; ++i) ss += h[i][0] * h[i][0] + h[i][1] * h[i][1] + h[i][2] * h[i][2] + h[i][3] * h[i][3];
        ss = wave_sum(ss);
        const float rstd = rsqrtf(ss * (1.0f / 1024.0f) + EPS);
        f32x4 v[4];
#pragma unroll
        for (int i = 0; i < 4; ++i) v[i] = h[i] * rstd * pa[i] + psh[i];
        if (WHICH == 2) {
#pragma unroll
            for (int i = 0; i < 4; ++i) *(f32x4*)(od + NCOL(i)) = v[i]; }
        else {
            float am = 0.f;
#pragma unroll
            for (int i = 0; i < 4; ++i) am = fmaxf(am, fmaxf(fmaxf(fabsf(v[i][0]), fabsf(v[i][1])), fmaxf(fabsf(v[i][2]), fabsf(v[i][3]))));
            am = fmaxf(wave_max(am), 1e-20f);
            const float qs = 127.0f / am;
            if (lane == 0) ((float*)(ws + WS_RS))[row] = am * (1.0f / 127.0f);
#pragma unroll
            for (int g = 0; g < 2; ++g) { u32x2 w; w.x = pk4_i8(v[2 * g][0] * qs, v[2 * g][1] * qs, v[2 * g][2] * qs, v[2 * g][3] * qs); w.y = pk4_i8(v[2 * g + 1][0] * qs, v[2 * g + 1][1] * qs, v[2 * g + 1][2] * qs, v[2 * g + 1][3] * qs);
                *(u32x2*)((unsigned char*)uout + (size_t)row * D + g * 512 + lane * 8) = w; } }
        if (router) {
            float lg8[8];
#pragma unroll
            for (int e = 0; e < 8; ++e) lg8[e] = 0.f;
#pragma unroll
            for (int i = 0; i < 4; ++i)
#pragma unroll
                for (int j = 0; j < 4; ++j) { const f32x4 wa = *(const LAS f32x4*)(RW + (((i * 4 + j) * 2) * 64 + lane) * 4), wb = *(const LAS f32x4*)(RW + (((i * 4 + j) * 2 + 1) * 64 + lane) * 4); const float x = v[i][j];
                    lg8[0] += x * wa[0]; lg8[1] += x * wa[1]; lg8[2] += x * wa[2]; lg8[3] += x * wa[3]; lg8[4] += x * wb[0]; lg8[5] += x * wb[1]; lg8[6] += x * wb[2]; lg8[7] += x * wb[3]; }
            {
                float a4[4], a2[2];
#pragma unroll
                for (int e = 0; e < 4; ++e) { const float mine = (lane & 32) ? lg8[e + 4] : lg8[e], send = (lane & 32) ? lg8[e] : lg8[e + 4]; a4[e] = mine + __shfl_xor(send, 32); }
#pragma unroll
                for (int e = 0; e < 2; ++e) { const float mine = (lane & 16) ? a4[e + 2] : a4[e], send = (lane & 16) ? a4[e] : a4[e + 2]; a2[e] = mine + __shfl_xor(send, 16); }
                float a1 = ((lane & 8) ? a2[1] : a2[0]) + __shfl_xor((lane & 8) ? a2[0] : a2[1], 8);
                a1 += __shfl_xor(a1, 4); a1 += __shfl_xor(a1, 2); a1 += __shfl_xor(a1, 1);
#pragma unroll
                for (int e = 0; e < 8; ++e) lg8[e] = __builtin_bit_cast(float, __builtin_amdgcn_readlane(__builtin_bit_cast(int, a1), e * 8));
            }
            int e0 = 0; float m0 = lg8[0];
#pragma unroll
            for (int e = 1; e < 8; ++e) if (lg8[e] > m0) { m0 = lg8[e]; e0 = e; }
            int e1 = -1; float m1 = -3.0e38f;
#pragma unroll
            for (int e = 0; e < 8; ++e) if (e != e0 && lg8[e] > m1) { m1 = lg8[e]; e1 = e; }
            if (e1 < 0) { e1 = (e0 + 1) & 7; m1 = m0; }
            const float w0 = 1.0f / (1.0f + __expf(m1 - m0)), w1 = 1.0f - w0;
            if (lane == 0) { f32x4 o; o[0] = __int_as_float(e0); o[1] = __int_as_float(e1); o[2] = w0; o[3] = w1; *(f32x4*)(route + (size_t)row * 4) = o; }
#pragma unroll
            for (int e = 0; e < 8; ++e) ecnt[e] += ((e0 == e) ? 1 : 0) + ((e1 == e) ? 1 : 0);
        }
    }
    if (router) {
        __syncthreads();
        LAS int* bc = (LAS int*)F.lds;
        if (tid < 8) bc[tid] = 0;
        __syncthreads();
        if (lane == 0) {
#pragma unroll
            for (int e = 0; e < 8; ++e) atomicAdd((int*)(bc + e), ecnt[e]); }
        __syncthreads();
        if (tid < 8) ((int*)(ws + WS_META + 4096))[F.bid * 8 + tid] = bc[tid];
        __syncthreads();
    }
}

__device__ __forceinline__ void ph_route_lists(const Frame& F, int l) {
    PH_LOCALS(F)
    const int row_lo = (l == 3) ? NCTX : 0, nrows = NTOK - row_lo, per = (nrows + F.G * 8 - 1) / (F.G * 8), rpb = per * 8;
    const int rb0 = row_lo + F.bid * rpb; const int rb1 = (rb0 + rpb < NTOK) ? rb0 + rpb : NTOK;
    LAS int* tot = (LAS int*)F.lds;
    LAS int* pre = tot + 8;
    LAS int* tb = pre + 8;
    LAS int* wc = tb + 16;
    const int* cnt = (const int*)(ws + WS_META + 4096);
    const int* route = (const int*)(ws + WS_ROUTE);
    int* meta = (int*)(ws + WS_META); int* list = (int*)(ws + WS_LIST);
    const float* rsc = (const float*)(ws + WS_RS); float* srs = (float*)(ws + WS_SRS);
    if (tid < 8) { int s = 0, p = 0; for (int b = 0; b < F.G; ++b) { const int c = cnt[b * 8 + tid]; if (b < F.bid) p += c; s += c; } tot[tid] = s; pre[tid] = p; }
    __syncthreads();
    if (tid == 0) { int s = 0; for (int e = 0; e < 8; ++e) { tb[e] = s; s += (tot[e] + 255) >> 8; } tb[8] = s;
        if (F.bid == 0) { for (int e = 0; e < 9; ++e) meta[e] = tb[e]; for (int e = 0; e < 8; ++e) meta[16 + e] = tot[e]; } }
    const int r = rb0 + wid * 64 + lane; const bool ok = r < rb1;
    int e0 = -1, e1 = -1; float myrs = 0.f;
    if (ok) { const u32x2 ee = *(const u32x2*)(route + (size_t)r * 4); e0 = (int)ee.x; e1 = (int)ee.y; myrs = rsc[r]; }
#pragma unroll
    for (int e = 0; e < 8; ++e) { const unsigned long long m0 = __ballot(e0 == e), m1 = __ballot(e1 == e); if (lane == 0) wc[wid * 8 + e] = __popcll(m0) + __popcll(m1); }
    __syncthreads();
    const unsigned long long lt = (1ull << lane) - 1ull;
#pragma unroll
    for (int e = 0; e < 8; ++e) { const unsigned long long m0 = __ballot(e0 == e), m1 = __ballot(e1 == e);
        int wp = 0; for (int w = 0; w < wid; ++w) wp += wc[w * 8 + e];
        const int base = tb[e] * 256 + pre[e] + wp;
        if (e0 == e) { const int p = base + __popcll(m0 & lt); list[p] = (r << 1); srs[p] = myrs; }
        if (e1 == e) { const int p = base + __popcll(m0) + __popcll(m1 & lt); list[p] = (r << 1) | 1; srs[p] = myrs; } }
    if (F.bid == 0 && tid < 8) { for (int p = tb[tid] * 256 + tot[tid]; p < tb[tid + 1] * 256; ++p) { list[p] = -1; srs[p] = 0.f; } }
    __syncthreads();
}

__device__ __forceinline__ void chunk_geom(int b, int dir, int c, int& rbase, int& cf) {
    if (dir == 0) { cf = c; rbase = (c < 4) ? b * 256 + 64 * c : NCTX + b * SEQ + 64 * (c - 4); }
    else { cf = (c < 4) ? 3 - c : 135 - c; rbase = (c < 4) ? b * 256 + 64 * (3 - c) : NCTX + b * SEQ + 64 * (131 - c); }
}
__device__ __forceinline__ u32x4 rev8(u32x4 v) {
    u32x4 r; r.x = (v.w >> 16) | (v.w << 16); r.y = (v.z >> 16) | (v.z << 16); r.z = (v.y >> 16) | (v.y << 16); r.w = (v.x >> 16) | (v.x << 16); return r;
}

__device__ __forceinline__ void ph_p0(const Frame& F, int l) {
    PH_LOCALS(F)
    const int fr = lane & 15, fq = lane >> 4;
    LAS bf16* Bq = (LAS bf16*)F.lds;
    LAS bf16* Bz = Bq + 64 * 136;
    LAS bf16* Bkr = Bz + 64 * 136;
    LAS bf16* Bqt = Bkr + 64 * 136;
    LAS bf16* Bv = Bqt + 64 * 136;
    LAS bf16* Bkh = Bv + 64 * 136;
    LAS bf16* Bfar = Bkh + 128 * 72;
    LAS bf16* Bas = Bfar + 3 * 16 * 136;
    LAS float* Fs = (LAS float*)(Bas + 64 * 72);
    const bf16* ZA = (const bf16*)(ws + WS_ZA); const bf16* ZB = (const bf16*)(ws + WS_ZB);
    const float* LB = (const float*)(ws + WS_LB);
    u32x4* QF = (u32x4*)(ws + WS_QF); u32x4* KF = (u32x4*)(ws + WS_KF); u32x4* AF = (u32x4*)(ws + WS_AF); u32x4* VF = (u32x4*)(ws + WS_VF);
    float* DEC = (float*)(ws + WS_DEC);
    u32x4 pq[2], pz[2];
#define P0_PRELOAD(u_) do { const int dir_ = (u_) & 1, h_ = ((u_) >> 1) & 3, bc_ = (u_) >> 3, c_ = bc_ % NCHUNK, b_ = bc_ / NCHUNK; int rb_, cf_; chunk_geom(b_, dir_, c_, rb_, cf_); (void)cf_; \
        _Pragma("unroll") for (int i_ = 0; i_ < 2; ++i_) { const int p_ = tid + NTHR * i_, rr_ = p_ >> 4, c8_ = (p_ & 15) * 8; const int srow_ = rb_ + (dir_ ? 63 - rr_ : rr_); \
            pq[i_] = *(const u32x4*)(ZA + (size_t)srow_ * ZW + h_ * 128 + c8_); pz[i_] = *(const u32x4*)(ZA + (size_t)srow_ * ZW + 512 + dir_ * 512 + h_ * 128 + c8_); } } while (0)
    if (F.bid < NUNIT_P0) P0_PRELOAD(F.bid);
    for (int u = F.bid; u < NUNIT_P0; u += F.G) {
        const int dir = u & 1, h = (u >> 1) & 3, bc = u >> 3, c = bc % NCHUNK, b = bc / NCHUNK;
        const int uo = ((b * 4 + h) * 2 + dir) * NCHUNK + c;
        int rbase, cf; chunk_geom(b, dir, c, rbase, cf);
#pragma unroll
        for (int i = 0; i < 2; ++i) { const int p = tid + NTHR * i, rr = p >> 4, c8 = (p & 15) * 8;
            *(LAS u32x4*)(Bq + rr * 136 + c8) = pq[i]; *(LAS u32x4*)(Bz + rr * 136 + c8) = pz[i]; }
        __syncthreads();
        if (u + F.G < NUNIT_P0) P0_PRELOAD(u + F.G);
        const int si = tid >> 7, k = tid & 127;
        float fv[16], kv[16], qp[16], kr[16];
        {
            const float lbv = LB[(l * 2 + dir) * 512 + h * 128 + k], oml = 1.0f - lbv;
            float p = 1.0f;
#pragma unroll
            for (int t = 0; t < 16; ++t) { const int idx = (16 * si + t) * 136 + k;
                const float zf = bf2f(Bz[idx]), q = bf2f(Bq[idx]);
                const float w = __expf(fminf(-zf, 80.0f)), r1 = __builtin_amdgcn_rcpf(1.0f + w);
                const float f = (1.0f + lbv * w) * r1, kk = oml * w * r1;
                p *= f; fv[t] = f; kv[t] = kk; qp[t] = q * QSCALE * p;
                Bq[idx] = f2bf(qp[t]); Bz[idx] = f2bf(kk * __builtin_amdgcn_rcpf(fmaxf(p, 1e-30f))); }
            Fs[si * 128 + k] = p;
            float r = 1.0f;
#pragma unroll
            for (int t = 15; t >= 0; --t) { kr[t] = kv[t] * r; r *= fv[t]; Bkr[(16 * si + t) * 136 + k] = f2bf(kr[t]); }
        }
        __syncthreads();
        {
            const float F0 = Fs[k], F1 = Fs[128 + k], F2 = Fs[256 + k], F3 = Fs[384 + k];
            const float Gm = si == 0 ? 1.0f : si == 1 ? F0 : si == 2 ? F0 * F1 : F0 * F1 * F2;
            const float Hm = si == 3 ? 1.0f : si == 2 ? F3 : si == 1 ? F2 * F3 : F1 * F2 * F3;
#pragma unroll
            for (int t = 0; t < 16; ++t) Bqt[(16 * si + t) * 136 + k] = f2bf(qp[t] * Gm);
#pragma unroll
            for (int t = 0; t < 16; t += 2) *(LAS unsigned*)(Bkh + k * 72 + 16 * si + t) = pk2(kr[t] * Hm, kr[t + 1] * Hm);
            if (si == 0) {
#pragma unroll
                for (int t = 0; t < 16; ++t) { Bfar[(0 * 16 + t) * 136 + k] = f2bf(kr[t] * F1); Bfar[(2 * 16 + t) * 136 + k] = f2bf(kr[t] * F1 * F2); }
                DEC[(size_t)uo * 128 + ((k >> 2) & 3) * 32 + (k >> 4) * 4 + (k & 3)] = F0 * F1 * F2 * F3; }
            if (si == 1) {
#pragma unroll
                for (int t = 0; t < 16; ++t) Bfar[(1 * 16 + t) * 136 + k] = f2bf(kr[t] * F2); }
        }
        __syncthreads();
        if (wid < 4) {
            const int rho = wid;
            for (int j = 0; j < 4; ++j) {
                if (j <= rho) {
                    const LAS bf16* Kx = (j == rho) ? Bz + 16 * j * 136 : (j == rho - 1) ? Bkr + 16 * j * 136 : Bfar + ((rho == 2) ? 0 : (j == 1 ? 1 : 2)) * 16 * 136;
                    f32x4 acc = (f32x4){0.f, 0.f, 0.f, 0.f};
#pragma unroll
                    for (int kq = 0; kq < 4; ++kq) { const bf16x8 av = *(const LAS bf16x8*)(Bq + (16 * rho + fr) * 136 + 32 * kq + 8 * fq); const bf16x8 bv = *(const LAS bf16x8*)(Kx + fr * 136 + 32 * kq + 8 * fq);
                        acc = __builtin_amdgcn_mfma_f32_16x16x32_bf16(av, bv, acc, 0, 0, 0); }
#pragma unroll
                    for (int e = 0; e < 4; ++e) { const float val = (j < rho || fr <= 4 * fq + e) ? acc[e] : 0.f; Bas[(16 * rho + 4 * fq + e) * 72 + 16 * j + fr] = f2bf(val); }
                } else {
#pragma unroll
                    for (int e = 0; e < 4; ++e) Bas[(16 * rho + 4 * fq + e) * 72 + 16 * j + fr] = 0;
                }
            }
        } else {
            const int w4 = wid - 4;
#pragma unroll
            for (int kq = 0; kq < 4; ++kq) { const int t = 16 * w4 + fr;
                const u32x2 lo = *(const LAS u32x2*)(Bqt + t * 136 + 32 * kq + 4 * fq), hi = *(const LAS u32x2*)(Bqt + t * 136 + 32 * kq + 16 + 4 * fq);
                QF[((size_t)uo * 16 + w4 * 4 + kq) * 64 + lane] = (u32x4){lo.x, lo.y, hi.x, hi.y}; }
#pragma unroll
            for (int dd = 0; dd < 2; ++dd)
#pragma unroll
                for (int sg = 0; sg < 2; ++sg) { const int d = 2 * w4 + dd, krow = 16 * d + fr;
                    const u32x4 vec = *(const LAS u32x4*)(Bkh + krow * 72 + 32 * sg + 8 * fq);
                    KF[((size_t)uo * 16 + d * 2 + sg) * 64 + lane] = vec; }
        }
        __syncthreads();
        if (wid < 6) {
            const int rho = wid < 2 ? wid : (wid < 4 ? 2 : 3), sl = (wid == 3 || wid == 5) ? 1 : 0; const int t = 16 * rho + fr;
            const u32x4 vec = *(const LAS u32x4*)(Bas + t * 72 + 32 * sl + 8 * fq);
            AF[((size_t)uo * 8 + wid) * 64 + lane] = vec;
        }
        __syncthreads();
    }
}

__device__ __forceinline__ void ph_pool1(const Frame& F, int pw, int npw) {
    PH_LOCALS(F)
    const bf16* ZB = (const bf16*)(ws + WS_ZB); bf16* P1 = (bf16*)(ws + WS_POOL1);
    const int g = lane >> 4, kwin = 2 << g, lo = kwin >> 1, hi = kwin - 1 - lo;
    const int nw = npw * 8;
#define P1_ACC(s_, v_, m_) do { (s_)[0] += (m_) * bflo((v_).x); (s_)[1] += (m_) * bfhi((v_).x); (s_)[2] += (m_) * bflo((v_).y); (s_)[3] += (m_) * bfhi((v_).y); (s_)[4] += (m_) * bflo((v_).z); (s_)[5] += (m_) * bfhi((v_).z); (s_)[6] += (m_) * bflo((v_).w); (s_)[7] += (m_) * bfhi((v_).w); } while (0)
#define P1_TAP(c_) (*(const u32x4*)(ZB + (size_t)(NCTX + tok0 + (c_)) * ZW + 1024 + lane * 8))
    for (int it = pw * 8 + wid; it < NLAT / 64; it += nw) {
        const int tok0 = it * 64;
        float s[8];
#pragma unroll
        for (int e = 0; e < 8; ++e) s[e] = 0.f;
        {
            u32x4 tv[8];
#pragma unroll
            for (int t = 0; t < 8; ++t) tv[t] = P1_TAP(t <= hi ? t : 0);
#pragma unroll
            for (int t = 0; t < 8; ++t) { const float mm = (t <= hi) ? 1.0f : 0.0f; P1_ACC(s, tv[t], mm); }
        }
        u32x4 a1 = P1_TAP(1 + hi <= 63 ? 1 + hi : 0), b1 = P1_TAP(0), a2 = P1_TAP(2 + hi <= 63 ? 2 + hi : 0), b2 = P1_TAP(1 - lo >= 0 ? 1 - lo : 0);
        for (int c = 0; c < 64; ++c) {
            u32x4 o; o.x = pk2(s[0], s[1]); o.y = pk2(s[2], s[3]); o.z = pk2(s[4], s[5]); o.w = pk2(s[6], s[7]);
            *(u32x4*)(P1 + (size_t)(tok0 + c) * 512 + lane * 8) = o;
            { const int cn = c + 1; const float ma = (cn + hi <= 63) ? 1.0f : 0.0f, mb = (cn - 1 - lo >= 0) ? -1.0f : 0.0f; P1_ACC(s, a1, ma); P1_ACC(s, b1, mb); }
            a1 = a2; b1 = b2;
            { const int cn = c + 3, ca = cn + hi, cb = cn - 1 - lo; a2 = P1_TAP((ca <= 63) ? ca : 0); b2 = P1_TAP((cb >= 0 && cb <= 63) ? cb : 0); }
        }
    }
#undef P1_ACC
#undef P1_TAP
}

__device__ __forceinline__ void ph_scan(const Frame& F, int l) {
    PH_LOCALS(F)
    const int fr = lane & 15, fq = lane >> 4, vt = wid;
    const u32x4* QF = (const u32x4*)(ws + WS_QF); const u32x4* KF = (const u32x4*)(ws + WS_KF); const u32x4* AF = (const u32x4*)(ws + WS_AF); const u32x4* VF = (const u32x4*)(ws + WS_VF);
    const float* DEC = (const float*)(ws + WS_DEC);
    bf16* O = (bf16*)(ws + WS_ZA);
    for (int chain = F.bid; chain < 64; chain += F.G) {
        const int b = chain >> 3, h = (chain >> 1) & 3, dir = chain & 1;
        f32x4 S[8];
#pragma unroll
        for (int d = 0; d < 8; ++d) S[d] = (f32x4){0.f, 0.f, 0.f, 0.f};
        for (int c = 0; c < NCHUNK; ++c) {
            const int uo = chain * NCHUNK + c; int rbase, cf; chunk_geom(b, dir, c, rbase, cf);
            const u32x4* qf = QF + (size_t)uo * 16 * 64 + lane; const u32x4* kf = KF + (size_t)uo * 16 * 64 + lane; const u32x4* af = AF + (size_t)uo * 8 * 64 + lane;
            const u32x4* vf = VF + ((size_t)((b * 4 + h) * NCHUNK + cf) * 16 + vt * 2) * 64 + lane;
            const f32x4* dc = (const f32x4*)(DEC + (size_t)uo * 128 + fq * 32);
            bf16x8 vv0 = __builtin_bit_cast(bf16x8, vf[0]), vv1 = __builtin_bit_cast(bf16x8, vf[64]);
            f32x4 o[4];
#pragma unroll
            for (int r = 0; r < 4; ++r) o[r] = (f32x4){0.f, 0.f, 0.f, 0.f};
            bf16x8 sf[4];
#pragma unroll
            for (int kq = 0; kq < 4; ++kq) { u32x4 p; p.x = pk2(S[2 * kq][0], S[2 * kq][1]); p.y = pk2(S[2 * kq][2], S[2 * kq][3]); p.z = pk2(S[2 * kq + 1][0], S[2 * kq + 1][1]); p.w = pk2(S[2 * kq + 1][2], S[2 * kq + 1][3]); sf[kq] = __builtin_bit_cast(bf16x8, p); }
#pragma unroll
            for (int r = 0; r < 4; ++r)
#pragma unroll
                for (int kq = 0; kq < 4; ++kq) { const bf16x8 qv = __builtin_bit_cast(bf16x8, qf[(r * 4 + kq) * 64]); o[r] = __builtin_amdgcn_mfma_f32_16x16x32_bf16(sf[kq], qv, o[r], 0, 0, 0); }
            const bf16x8 va = dir ? vv1 : vv0, vb = dir ? vv0 : vv1;
            { const bf16x8 a0 = __builtin_bit_cast(bf16x8, af[0]), a1 = __builtin_bit_cast(bf16x8, af[64]), a2 = __builtin_bit_cast(bf16x8, af[128]), a3 = __builtin_bit_cast(bf16x8, af[192]), a4 = __builtin_bit_cast(bf16x8, af[256]), a5 = __builtin_bit_cast(bf16x8, af[320]);
              o[0] = __builtin_amdgcn_mfma_f32_16x16x32_bf16(va, a0, o[0], 0, 0, 0);
              o[1] = __builtin_amdgcn_mfma_f32_16x16x32_bf16(va, a1, o[1], 0, 0, 0);
              o[2] = __builtin_amdgcn_mfma_f32_16x16x32_bf16(va, a2, o[2], 0, 0, 0);
              o[2] = __builtin_amdgcn_mfma_f32_16x16x32_bf16(vb, a3, o[2], 0, 0, 0);
              o[3] = __builtin_amdgcn_mfma_f32_16x16x32_bf16(va, a4, o[3], 0, 0, 0);
              o[3] = __builtin_amdgcn_mfma_f32_16x16x32_bf16(vb, a5, o[3], 0, 0, 0); }
#pragma unroll
            for (int r = 0; r < 4; ++r) { const int t = 16 * r + fr; const int row = rbase + (dir ? 63 - t : t);
                u32x2 w; w.x = pk2(o[r][0], o[r][1]); w.y = pk2(o[r][2], o[r][3]);
                *(u32x2*)(O + (size_t)row * 1024 + dir * 512 + h * 128 + 16 * vt + 4 * fq) = w; }
#pragma unroll
            for (int d = 0; d < 8; ++d) { S[d] = S[d] * dc[d];
                const bf16x8 k0 = __builtin_bit_cast(bf16x8, kf[(d * 2) * 64]), k1 = __builtin_bit_cast(bf16x8, kf[(d * 2 + 1) * 64]);
                S[d] = __builtin_amdgcn_mfma_f32_16x16x32_bf16(k0, vv0, S[d], 0, 0, 0);
                S[d] = __builtin_amdgcn_mfma_f32_16x16x32_bf16(k1, vv1, S[d], 0, 0, 0); }
        }
    }
}

constexpr int SC_QF = 0, SC_KF = 16384, SC_AF = 32768, SC_DEC = 38912, SC_VF = 39936, SC_SLOT = 48128;
#define SC_BAR() do { asm volatile("" ::: "memory"); __builtin_amdgcn_s_barrier(); asm volatile("" ::: "memory"); } while (0)
__device__ __forceinline__ void ph_scan2(const Frame& F, int l) {
    PH_LOCALS(F)
    const int fr = lane & 15, fq = lane >> 4;
    int sb, pw, npw;
    if (F.G == 256) { const int xcd = F.bid & 7, idx = F.bid >> 3; sb = idx < 16 ? xcd * 16 + idx : -1; pw = xcd * 16 + (idx - 16); npw = 128; }
    else { sb = F.bid < 128 ? F.bid : -1; pw = F.G > 128 ? F.bid - 128 : F.bid; npw = F.G > 128 ? F.G - 128 : F.G; }
    if (sb >= 0) {
        const int chain = sb >> 1, vhalf = sb & 1, b = chain >> 3, h = (chain >> 1) & 3, dir = chain & 1;
        if (wid >= 4) {
            const int lw = wid - 4;
            const char* gQF = (const char*)(ws + WS_QF) + (size_t)chain * NCHUNK * 16384 + lane * 16;
            const char* gKF = (const char*)(ws + WS_KF) + (size_t)chain * NCHUNK * 16384 + lane * 16;
            const char* gAF = (const char*)(ws + WS_AF) + (size_t)chain * NCHUNK * 8192 + lane * 16;
            const char* gDEC = (const char*)(ws + WS_DEC) + (size_t)chain * NCHUNK * 512 + lane * 16;
            const char* gV = (const char*)(ws + WS_ZB) + (size_t)(h * 128 + vhalf * 64) * 2 + (lane & 7) * 16;
#define SC_ISSUE(c_, slot_) do { const int cc_ = (c_) < NCHUNK ? (c_) : NCHUNK - 1; int rb_, cf_; chunk_geom(b, dir, cc_, rb_, cf_); (void)cf_; \
            _Pragma("unroll") for (int j_ = 0; j_ < 12; ++j_) { const int i_ = lw + 4 * j_; const char* src_; int off_; \
                if (i_ < 16) { src_ = gQF + (size_t)cc_ * 16384 + i_ * 1024; off_ = SC_QF + i_ * 1024; } \
                else if (i_ < 32) { src_ = gKF + (size_t)cc_ * 16384 + (i_ - 16) * 1024; off_ = SC_KF + (i_ - 16) * 1024; } \
                else if (i_ < 38) { src_ = gAF + (size_t)cc_ * 8192 + (i_ - 32) * 1024; off_ = SC_AF + (i_ - 32) * 1024; } \
                else if (i_ == 38 || i_ == 47) { src_ = gDEC + (size_t)cc_ * 512; off_ = SC_DEC; } \
                else { const int s_ = 8 * (i_ - 39) + (lane >> 3); src_ = gV + (size_t)(rb_ + (dir ? 63 - s_ : s_)) * (ZW * 2); off_ = SC_VF + (i_ - 39) * 1024; } \
                __builtin_amdgcn_global_load_lds((const unsigned*)src_, (LAS unsigned*)(F.lds + (slot_) * SC_SLOT + off_), 16, 0, 0); } } while (0)
            SC_ISSUE(0, 0); SC_ISSUE(1, 1);
            asm volatile("s_waitcnt vmcnt(12)" ::: "memory");
            SC_BAR();
            int slot = 2;
            for (int c = 0; c < NCHUNK; ++c) {
                SC_ISSUE(c + 2, slot);
                asm volatile("s_waitcnt vmcnt(12)" ::: "memory");
                SC_BAR();
                slot = slot == 2 ? 0 : slot + 1;
            }
            asm volatile("s_waitcnt vmcnt(0)" ::: "memory");
#undef SC_ISSUE
        } else {
            const int vt = vhalf * 4 + wid;
            bf16* O = (bf16*)(ws + WS_ZA);
            f32x4 S[8];
#pragma unroll
            for (int d = 0; d < 8; ++d) S[d] = (f32x4){0.f, 0.f, 0.f, 0.f};
            SC_BAR();
            int slot = 0;
            for (int c = 0; c < NCHUNK; ++c) {
                int rbase, cf; chunk_geom(b, dir, c, rbase, cf); (void)cf;
                const LAS unsigned char* sl = F.lds + slot * SC_SLOT + lane * 16;
                bf16x8 vv0, vv1;
                { const LAS bf16* vt_ = (const LAS bf16*)(F.lds + slot * SC_SLOT + SC_VF) + 16 * wid + fr;
#pragma unroll
                  for (int e = 0; e < 8; ++e) { vv0[e] = (short)vt_[(8 * fq + e) * 64]; vv1[e] = (short)vt_[(32 + 8 * fq + e) * 64]; } }
                f32x4 o[4];
#pragma unroll
                for (int r = 0; r < 4; ++r) o[r] = (f32x4){0.f, 0.f, 0.f, 0.f};
                bf16x8 sf[4];
#pragma unroll
                for (int kq = 0; kq < 4; ++kq) { u32x4 p; p.x = pk2(S[2 * kq][0], S[2 * kq][1]); p.y = pk2(S[2 * kq][2], S[2 * kq][3]); p.z = pk2(S[2 * kq + 1][0], S[2 * kq + 1][1]); p.w = pk2(S[2 * kq + 1][2], S[2 * kq + 1][3]); sf[kq] = __builtin_bit_cast(bf16x8, p); }
#pragma unroll
                for (int r = 0; r < 4; ++r)
#pragma unroll
                    for (int kq = 0; kq < 4; ++kq) { const bf16x8 qv = *(const LAS bf16x8*)(sl + SC_QF + (r * 4 + kq) * 1024); o[r] = __builtin_amdgcn_mfma_f32_16x16x32_bf16(sf[kq], qv, o[r], 0, 0, 0); }
                const bf16x8 va = vv0, vb = vv1;
                { const bf16x8 a0 = *(const LAS bf16x8*)(sl + SC_AF), a1 = *(const LAS bf16x8*)(sl + SC_AF + 1024), a2 = *(const LAS bf16x8*)(sl + SC_AF + 2048), a3 = *(const LAS bf16x8*)(sl + SC_AF + 3072), a4 = *(const LAS bf16x8*)(sl + SC_AF + 4096), a5 = *(const LAS bf16x8*)(sl + SC_AF + 5120);
                  o[0] = __builtin_amdgcn_mfma_f32_16x16x32_bf16(va, a0, o[0], 0, 0, 0);
                  o[1] = __builtin_amdgcn_mfma_f32_16x16x32_bf16(va, a1, o[1], 0, 0, 0);
                  o[2] = __builtin_amdgcn_mfma_f32_16x16x32_bf16(va, a2, o[2], 0, 0, 0);
                  o[2] = __builtin_amdgcn_mfma_f32_16x16x32_bf16(vb, a3, o[2], 0, 0, 0);
                  o[3] = __builtin_amdgcn_mfma_f32_16x16x32_bf16(va, a4, o[3], 0, 0, 0);
                  o[3] = __builtin_amdgcn_mfma_f32_16x16x32_bf16(vb, a5, o[3], 0, 0, 0); }
#pragma unroll
                for (int r = 0; r < 4; ++r) { const int t = 16 * r + fr; const int row = rbase + (dir ? 63 - t : t);
                    u32x2 w; w.x = pk2(o[r][0], o[r][1]); w.y = pk2(o[r][2], o[r][3]);
                    *(u32x2*)(O + (size_t)row * 1024 + dir * 512 + h * 128 + 16 * vt + 4 * fq) = w; }
                const LAS unsigned char* sd = F.lds + slot * SC_SLOT + SC_DEC + fq * 128;
#pragma unroll
                for (int d = 0; d < 8; ++d) { S[d] = S[d] * *(const LAS f32x4*)(sd + d * 16);
                    const bf16x8 k0 = *(const LAS bf16x8*)(sl + SC_KF + (d * 2) * 1024), k1 = *(const LAS bf16x8*)(sl + SC_KF + (d * 2 + 1) * 1024);
                    S[d] = __builtin_amdgcn_mfma_f32_16x16x32_bf16(k0, vv0, S[d], 0, 0, 0);
                    S[d] = __builtin_amdgcn_mfma_f32_16x16x32_bf16(k1, vv1, S[d], 0, 0, 0); }
                asm volatile("s_waitcnt lgkmcnt(0)" ::: "memory");
                SC_BAR();
                slot = slot == 2 ? 0 : slot + 1;
            }
        }
        __syncthreads();
    }
    if (sb < 0 || F.G <= 128) { ph_pool1(F, pw, npw); wprep_run(F, 1, l >> 1, (l & 1) * (WT_MOE / 2), ((l & 1) + 1) * (WT_MOE / 2), pw, npw); }
}

#define RO_FINISH(row_, of_, ob_, gg_, pv_, s_, inv_) do { \
        float o_[8], gv_[8]; \
        o_[0] = bflo((of_).x) + bflo((ob_).x); o_[1] = bfhi((of_).x) + bfhi((ob_).x); o_[2] = bflo((of_).y) + bflo((ob_).y); o_[3] = bfhi((of_).y) + bfhi((ob_).y); \
        o_[4] = bflo((of_).z) + bflo((ob_).z); o_[5] = bfhi((of_).z) + bfhi((ob_).z); o_[6] = bflo((of_).w) + bflo((ob_).w); o_[7] = bfhi((of_).w) + bfhi((ob_).w); \
        gv_[0] = bflo((gg_).x); gv_[1] = bfhi((gg_).x); gv_[2] = bflo((gg_).y); gv_[3] = bfhi((gg_).y); gv_[4] = bflo((gg_).z); gv_[5] = bfhi((gg_).z); gv_[6] = bflo((gg_).w); gv_[7] = bfhi((gg_).w); \
        float ss_ = 0.f; \
        _Pragma("unroll") for (int e = 0; e < 8; ++e) ss_ += o_[e] * o_[e]; \
        ss_ = row16_sum(ss_); \
        const float rs_ = rsqrtf(ss_ * (1.0f / 128.0f) + EPS); \
        float r_[8], pp_[8]; \
        _Pragma("unroll") for (int e = 0; e < 8; ++e) r_[e] = o_[e] * rs_ * nwv[e] * siluf(gv_[e]); \
        pp_[0] = ((s_)[0] * (inv_) - bflo((pv_).x)) * psc[0]; pp_[1] = ((s_)[1] * (inv_) - bfhi((pv_).x)) * psc[1]; pp_[2] = ((s_)[2] * (inv_) - bflo((pv_).y)) * psc[2]; pp_[3] = ((s_)[3] * (inv_) - bfhi((pv_).y)) * psc[3]; \
        pp_[4] = ((s_)[4] * (inv_) - bflo((pv_).z)) * psc[4]; pp_[5] = ((s_)[5] * (inv_) - bfhi((pv_).z)) * psc[5]; pp_[6] = ((s_)[6] * (inv_) - bflo((pv_).w)) * psc[6]; pp_[7] = ((s_)[7] * (inv_) - bfhi((pv_).w)) * psc[7]; \
        float am_ = 0.f; \
        _Pragma("unroll") for (int e = 0; e < 8; ++e) am_ = fmaxf(am_, fmaxf(fabsf(r_[e]), fabsf(pp_[e]))); \
        am_ = fmaxf(wave_max(am_), 1e-20f); \
        const float qs_ = 127.0f / am_; \
        if (lane == 0) ((float*)(ws + WS_RS))[row_] = am_ * (1.0f / 127.0f); \
        u32x2 wa_; wa_.x = pk4_i8(r_[0] * qs_, r_[1] * qs_, r_[2] * qs_, r_[3] * qs_); wa_.y = pk4_i8(r_[4] * qs_, r_[5] * qs_, r_[6] * qs_, r_[7] * qs_); \
        *(u32x2*)(R8 + (size_t)(row_) * 1024 + lane * 8) = wa_; \
        u32x2 wp_; wp_.x = pk4_i8(pp_[0] * qs_, pp_[1] * qs_, pp_[2] * qs_, pp_[3] * qs_); wp_.y = pk4_i8(pp_[4] * qs_, pp_[5] * qs_, pp_[6] * qs_, pp_[7] * qs_); \
        *(u32x2*)(R8 + (size_t)(row_) * 1024 + 512 + lane * 8) = wp_; } while (0)
#define RO_ACC(s_, v_, m_) do { (s_)[0] += (m_) * bflo((v_).x); (s_)[1] += (m_) * bfhi((v_).x); (s_)[2] += (m_) * bflo((v_).y); (s_)[3] += (m_) * bfhi((v_).y); (s_)[4] += (m_) * bflo((v_).z); (s_)[5] += (m_) * bfhi((v_).z); (s_)[6] += (m_) * bflo((v_).w); (s_)[7] += (m_) * bfhi((v_).w); } while (0)
__device__ __forceinline__ void ph_readout(const Frame& F, int l) {
    const Args& a = *F.a; PH_LOCALS(F)
    const bf16* O = (const bf16*)(ws + WS_ZA); const bf16* ZB = (const bf16*)(ws + WS_ZB); const bf16* P1 = (const bf16*)(ws + WS_POOL1);
    unsigned char* R8 = (unsigned char*)(ws + WS_R1);
    const int g = lane >> 4, kwin = 2 << g, lo = kwin >> 1, hi = kwin - 1 - lo;
    float nwv[8], psc[8];
#pragma unroll
    for (int e = 0; e < 8; ++e) { nwv[e] = a.in[IN_HNORMW][l * 512 + lane * 8 + e]; psc[e] = a.in[IN_PSCALE][l * 512 + lane * 8 + e]; }
    const int nw = F.G * 8, gw = F.bid * 8 + wid;
    struct Tok { u32x4 of, ob, gg, pv, pa, pb; };
#define RO_LOAD(T, r_) do { const int rowL_ = NCTX + tok0 + (r_) * 64; \
        (T).of = *(const u32x4*)(O + (size_t)rowL_ * 1024 + lane * 8); (T).ob = *(const u32x4*)(O + (size_t)rowL_ * 1024 + 512 + lane * 8); \
        (T).gg = *(const u32x4*)(ZB + (size_t)rowL_ * ZW + 512 + lane * 8); (T).pv = *(const u32x4*)(ZB + (size_t)rowL_ * ZW + 1024 + lane * 8); \
        const int ra_ = (r_) + hi, rb_ = (r_) - 1 - lo; \
        (T).pa = *(const u32x4*)(P1 + (size_t)(tok0 + (ra_ <= 127 ? ra_ : (r_)) * 64) * 512 + lane * 8); \
        (T).pb = *(const u32x4*)(P1 + (size_t)(tok0 + (rb_ >= 0 ? rb_ : (r_)) * 64) * 512 + lane * 8); } while (0)
    for (int it = gw; it < NB * 64 * 4; it += nw) {
        const int b = it >> 8, c = (it >> 2) & 63, r0 = (it & 3) * 32, tok0 = b * SEQ + c;
        const int c0 = (c - lo < 0) ? 0 : c - lo, c1 = (c + hi > 63) ? 63 : c + hi; const float ncol = (float)(c1 - c0 + 1);
        float s[8];
#pragma unroll
        for (int e = 0; e < 8; ++e) s[e] = 0.f;
        {
            const int g0 = (r0 - lo < 0) ? 0 : r0 - lo, g1 = (r0 + hi > 127) ? 127 : r0 + hi;
            u32x4 tv[16];
#pragma unroll
            for (int t = 0; t < 16; ++t) { const int rr = r0 - lo + t; const bool ok = (t < kwin) && rr >= g0 && rr <= g1; tv[t] = *(const u32x4*)(P1 + (size_t)(tok0 + (ok ? rr : r0) * 64) * 512 + lane * 8); }
#pragma unroll
            for (int t = 0; t < 16; ++t) { const int rr = r0 - lo + t; const float mm = ((t < kwin) && rr >= g0 && rr <= g1) ? 1.0f : 0.0f; RO_ACC(s, tv[t], mm); }
        }
        Tok cur, n1, n2;
        RO_LOAD(cur, r0); RO_LOAD(n1, r0 + 1); RO_LOAD(n2, r0 + 2);
        for (int r = r0; r < r0 + 32; ++r) {
            if (r > r0) { const float ma = (r + hi <= 127) ? 1.0f : 0.0f, mb = (r - 1 - lo >= 0) ? -1.0f : 0.0f; RO_ACC(s, cur.pa, ma); RO_ACC(s, cur.pb, mb); }
            const int g0 = (r - lo < 0) ? 0 : r - lo, g1 = (r + hi > 127) ? 127 : r + hi;
            const float inv = 1.0f / ((float)(g1 - g0 + 1) * ncol);
            const int row = NCTX + tok0 + r * 64;
            RO_FINISH(row, cur.of, cur.ob, cur.gg, cur.pv, s, inv);
            cur = n1; n1 = n2;
            if (r + 3 < r0 + 32) RO_LOAD(n2, r + 3);
        }
    }
    if (l < 3) for (int row = gw; row < NCTX; row += nw) {
        const u32x4 of = *(const u32x4*)(O + (size_t)row * 1024 + lane * 8), ob = *(const u32x4*)(O + (size_t)row * 1024 + 512 + lane * 8), gg = *(const u32x4*)(ZB + (size_t)row * ZW + 512 + lane * 8);
        const u32x4 pv = *(const u32x4*)(ZB + (size_t)row * ZW + 1024 + lane * 8);
        float s[8];
#pragma unroll
        for (int e = 0; e < 8; ++e) s[e] = 0.f;
        const int j = row & 255; const int j0 = (j - lo < 0) ? 0 : j - lo, j1 = (j + hi > 255) ? 255 : j + hi;
        u32x4 tv[16];
#pragma unroll
        for (int t = 0; t < 16; ++t) { const int jj = j - lo + t; const bool ok = (t < kwin) && jj >= j0 && jj <= j1; tv[t] = *(const u32x4*)(ZB + (size_t)(row - j + (ok ? jj : j)) * ZW + 1024 + lane * 8); }
#pragma unroll
        for (int t = 0; t < 16; ++t) { const int jj = j - lo + t; const float mm = ((t < kwin) && jj >= j0 && jj <= j1) ? 1.0f : 0.0f; RO_ACC(s, tv[t], mm); }
        const float inv = 1.0f / (float)(j1 - j0 + 1);
        RO_FINISH(row, of, ob, gg, pv, s, inv);
    }
#undef RO_LOAD
}
#undef RO_FINISH
#undef RO_ACC

constexpr int PH_FINAL = 49, PH_END = 50;
#ifndef PHMASK
#define PHMASK 0xFFFF
#endif
#define SITE(k) ((PM >> (k)) & 1)
#ifdef DBLMASK
#define NREP(k) (1 + ((a.dbl >> (k)) & 1))
#else
#define DBLMASK 0
#define NREP(k) 1
#endif
template <int PM> __global__ void __launch_bounds__(NTHR, 2) mega(Args a) {
    extern __shared__ __attribute__((aligned(16))) unsigned char lds_raw[];
    Frame F; F.a = &a; F.ws = a.ws; F.lds = (LAS unsigned char*)lds_raw; F.tid = threadIdx.x; F.lane = F.tid & 63; F.wid = __builtin_amdgcn_readfirstlane(F.tid >> 6); F.G = gridDim.x; F.bid = blockIdx.x;
    volatile LAS unsigned* MISC = (volatile LAS unsigned*)(F.lds + LDS_MISC);
    if (F.tid < 4) MISC[F.tid] = 0u;
    __syncthreads();
    const bool multi = (a.ph_hi - a.ph_lo) > 1;
    XcdBarrier bar; bar.bar = (unsigned*)(a.ws + WS_CTL) + 4096; bar.x = 0; bar.st = MISC;
    if (multi) bar = xcd_barrier_post((unsigned*)(a.ws + WS_CTL) + 4096, MISC);
#define SEAM() do { if (multi) xcd_barrier(bar); } while (0)
#define RUN(p) (a.ph_lo <= (p) && (p) < a.ph_hi)
    unsigned char* ws = a.ws;
    if (SITE(0) && RUN(0)) _Pragma("nounroll") for (int rep_ = 0; rep_ < NREP(0); ++rep_) { ph_prologue(F); SEAM(); }
    for (int l = 0; l < DEPTH; ++l) {
        const int pb = 1 + 12 * l;
        if (SITE(1) && RUN(pb + 0)) _Pragma("nounroll") for (int rep_ = 0; rep_ < NREP(1); ++rep_) { ph_norm<0>(F, l); SEAM(); }
        if (SITE(2) && RUN(pb + 1)) _Pragma("nounroll") for (int rep_ = 0; rep_ < NREP(2); ++rep_) {
            pg8::StaticOrder S; S.init(NTOK / 256, DIN / 256, F.G, F.bid);
            pg8::EpiZQ E{(bf16*)(ws + WS_ZA), ZW, 6, (size_t)(WS_ZB - WS_ZA) / 2, (const float*)(ws + WS_RS), 1.0f / Q_SW1};
            pg8::gemm_phase<pg8::EpiZQ, pg8::StaticOrder, false, true>(F.lds, (const bf16*)(ws + WS_R1), (const bf16*)(ws + WS_WIN + (size_t)l * DIN * D), D / 2, S, E, nullptr);
            SEAM();
        }
        if (SITE(3) && RUN(pb + 2)) _Pragma("nounroll") for (int rep_ = 0; rep_ < NREP(3); ++rep_) { ph_p0(F, l); SEAM(); }
        if (SITE(4) && RUN(pb + 3)) _Pragma("nounroll") for (int rep_ = 0; rep_ < NREP(4); ++rep_) { ph_scan2(F, l); SEAM(); }
        if (SITE(5) && RUN(pb + 4)) _Pragma("nounroll") for (int rep_ = 0; rep_ < NREP(5); ++rep_) { ph_readout(F, l); SEAM(); }
        if (SITE(6) && RUN(pb + 5)) _Pragma("nounroll") for (int rep_ = 0; rep_ < NREP(6); ++rep_) {
            const int row_lo = (l == 3) ? NCTX : 0;
            pg8::StaticOrder S; S.init((NTOK - row_lo) / 256, D / 256, F.G, F.bid);
            pg8::EpiResid E{ws, l == 0 ? a.in[IN_CTX] : nullptr, l == 0 ? a.in[IN_X] : nullptr, (const float*)(ws + WS_MODS) + (size_t)(l * 9) * 6144 + 2 * 1024, row_lo, 1.0f / Q_SW1, (const float*)(ws + WS_RS)};
            pg8::gemm_phase<pg8::EpiResid, pg8::StaticOrder, false, true>(F.lds, (const bf16*)(ws + WS_R1 + (size_t)row_lo * D), (const bf16*)(ws + WS_WOUT + (size_t)l * D * D), D / 2, S, E, nullptr);
            SEAM();
        }
        if (SITE(7) && RUN(pb + 6)) _Pragma("nounroll") for (int rep_ = 0; rep_ < NREP(7); ++rep_) { ph_norm<1>(F, l); SEAM(); }
        if ((l & 1) == 0) {
            if (SITE(8) && RUN(pb + 7)) _Pragma("nounroll") for (int rep_ = 0; rep_ < NREP(8); ++rep_) {
                pg8::StaticOrder S; S.init(NTOK / 256, DFF / 128, F.G, F.bid);
                pg8::EpiSwiGLUQ E{ws + WS_ACT, DFF, DFF / 128, (const float*)(ws + WS_RS), 1.0f / Q_SW1, Q_SA};
                pg8::gemm_phase<pg8::EpiSwiGLUQ, pg8::StaticOrder, false, true>(F.lds, (const bf16*)(ws + WS_R1), (const bf16*)(ws + WS_WF1 + (size_t)(l >> 1) * 2 * DFF * D), D / 2, S, E, nullptr);
                SEAM();
            }
            if (SITE(9) && RUN(pb + 8)) _Pragma("nounroll") for (int rep_ = 0; rep_ < NREP(9); ++rep_) {
                pg8::StaticOrder S; S.init(NTOK / 256, D / 256, F.G, F.bid);
                pg8::EpiResid E{ws, nullptr, nullptr, (const float*)(ws + WS_MODS) + (size_t)(l * 9) * 6144 + 5 * 1024, 0, 1.0f / (Q_SA * Q_SW2D), nullptr};
                pg8::gemm_phase<pg8::EpiResid, pg8::StaticOrder, false, true>(F.lds, (const bf16*)(ws + WS_ACT), (const bf16*)(ws + WS_WF2 + (size_t)(l >> 1) * D * DFF), DFF / 2, S, E, nullptr);
                SEAM();
            }
        } else {
            if (SITE(10) && RUN(pb + 7)) _Pragma("nounroll") for (int rep_ = 0; rep_ < NREP(10); ++rep_) { ph_route_lists(F, l); SEAM(); }
            {
                const int* meta = (const int*)(ws + WS_META); const int* list = (const int*)(ws + WS_LIST);
                if (SITE(11) && RUN(pb + 8)) _Pragma("nounroll") for (int rep_ = 0; rep_ < NREP(11); ++rep_) {
                    pg8::MoeOrder S; S.init(meta, DFE / 128, F.G, F.bid);
                    pg8::EpiSwiGLUQ E{ws + WS_ACT, DFE, DFE / 128, (const float*)(ws + WS_SRS), 1.0f / Q_SW1, Q_SA};
                    pg8::gemm_phase<pg8::EpiSwiGLUQ, pg8::MoeOrder, true, true>(F.lds, (const bf16*)(ws + WS_R1), (const bf16*)(ws + WS_WM1), D / 2, S, E, list);
                    SEAM();
                }
                if (SITE(12) && RUN(pb + 9)) _Pragma("nounroll") for (int rep_ = 0; rep_ < NREP(12); ++rep_) {
                    pg8::MoeOrder S; S.init(meta, D / 256, F.G, F.bid);
                    pg8::EpiScatter E{(bf16*)(ws + WS_YB), list, D / 256, 1.0f / (Q_SA * Q_SW2)};
                    pg8::gemm_phase<pg8::EpiScatter, pg8::MoeOrder, false, true>(F.lds, (const bf16*)(ws + WS_ACT), (const bf16*)(ws + WS_WM2), DFE / 2, S, E, nullptr);
                    SEAM();
                }
            }
        }
    }
#ifdef PROBE_READ
    if (SITE(14) && RUN(60)) {
        const int lane = F.lane, gw = F.bid * 8 + F.wid, per = (NLAT + F.G * 8 - 1) / (F.G * 8);
        f32x4 s = (f32x4){0.f, 0.f, 0.f, 0.f};
        for (int row = gw * per; row < gw * per + per && row < NLAT; ++row) {
#pragma unroll
            for (int i = 0; i < 4; ++i) s += *(const f32x4*)(a.in[IN_X] + (size_t)row * D + i * 256 + lane * 4); }
        if (s[0] + s[1] + s[2] + s[3] == 123.456f) ((float*)(ws + WS_META + 32768))[gw] = s[0];
    }
#endif
    if (SITE(13) && RUN(PH_FINAL)) ph_norm<2>(F, 3);
#undef SEAM
#undef RUN
}

#ifdef DBG_CUT
__global__ void dbg_dump(const bf16* src, size_t n_src, float* out, size_t n_out) {
#ifdef DBG_F32
    for (size_t i = (size_t)blockIdx.x * blockDim.x + threadIdx.x; i < n_out; i += (size_t)gridDim.x * blockDim.x) { float s = 1.0f; for (size_t j = i; j < n_src; j += n_out) s += ((const float*)src)[j]; out[i] = s; }
#else
    for (size_t i = (size_t)blockIdx.x * blockDim.x + threadIdx.x; i < n_out; i += (size_t)gridDim.x * blockDim.x) { float s = 0.f; for (size_t j = i; j < n_src; j += n_out) { const float x = bf2f(src[j]); s += (x - x == 0.0f) ? x : 1000.0f; } out[i] = s; }
#endif
}
#endif
#ifndef HOSTDBL
#define HOSTDBL 0
#endif
extern "C" void kernel_launch(void* const* d_in, const int* in_sizes, int n_in, void* d_out, int out_size, void* d_ws, size_t ws_size, hipStream_t stream) {
    static int grid = 0;
    if (grid == 0) {
        if (n_in != 21 || in_sizes[0] != NLAT * D || out_size != NLAT * D || ws_size < WS_END) {
            fprintf(stderr, "kernel_launch: unexpected shapes / workspace (n_in %d, in0 %d, out %d, ws %zu, need %zu); nothing launched\n", n_in, n_in > 0 ? in_sizes[0] : -1, out_size, ws_size, (size_t)WS_END); grid = -1; return; }
        int dev = 0, cus = 0, per_cu = 0;
        if (hipGetDevice(&dev) != hipSuccess || hipDeviceGetAttribute(&cus, hipDeviceAttributeMultiprocessorCount, dev) != hipSuccess) { grid = -1; return; }
#if MK_ONE_LAUNCH
        if (hipFuncSetAttribute((const void*)mega<PHMASK>, hipFuncAttributeMaxDynamicSharedMemorySize, LDS_BYTES) != hipSuccess) { fprintf(stderr, "kernel_launch: hipFuncSetAttribute failed\n"); grid = -1; return; }
        if (hipOccupancyMaxActiveBlocksPerMultiprocessor(&per_cu, (const void*)mega<PHMASK>, NTHR, LDS_BYTES) != hipSuccess || per_cu < 1) { fprintf(stderr, "kernel_launch: occupancy query says %d\n", per_cu); }
#else
        { const void* fs[15] = {(const void*)mega<1>, (const void*)mega<2>, (const void*)mega<4>, (const void*)mega<8>, (const void*)mega<16>, (const void*)mega<32>, (const void*)mega<64>, (const void*)mega<128>, (const void*)mega<256>, (const void*)mega<512>, (const void*)mega<1024>, (const void*)mega<2048>, (const void*)mega<4096>, (const void*)mega<8192>, (const void*)mega<16384>};
          for (int i = 0; i < 15; ++i) if (hipFuncSetAttribute(fs[i], hipFuncAttributeMaxDynamicSharedMemorySize, LDS_BYTES) != hipSuccess) { grid = -1; return; } }
        (void)per_cu;
#endif
        (void)hipGetLastError();
        grid = cus;
    }
    if (grid < 0) return;
#ifdef DBG_TRIVIAL
    hipMemsetAsync(d_out, 0, (size_t)out_size * 4, stream); return;
#endif
    if (hipMemsetAsync((char*)d_ws + WS_CTL, 0, CTL_BYTES, stream) != hipSuccess) return;
    Args a{};
    for (int i = 0; i < 21; ++i) a.in[i] = (const float*)d_in[i];
    a.out = (float*)d_out; a.ws = (unsigned char*)d_ws; a.dbl = DBLMASK;
#ifdef PROBE_READ
    { Args a2 = a; a2.ph_lo = 60; a2.ph_hi = 61; for (int r = 0; r < PROBE_READ; ++r) hipLaunchKernelGGL(mega<(1 << 14)>, dim3(grid), dim3(NTHR), LDS_BYTES, stream, a2); }
#endif
#if MK_ONE_LAUNCH
    a.ph_lo = 0; a.ph_hi = PH_END;
    hipLaunchKernelGGL(mega<PHMASK>, dim3(grid), dim3(NTHR), LDS_BYTES, stream, a);
#else
    for (int p = 0; p < PH_END; ++p) {
        if (p >= 1 && p < PH_FINAL) { const int l = (p - 1) / 12, j = (p - 1) % 12; if (((l & 1) == 0 && j > 8) || j > 9) continue; }
#ifdef DBG_CUT
        if (p >= DBG_CUT) break;
#endif
        a.ph_lo = p; a.ph_hi = p + 1;
        int site = 0;
        if (p == PH_FINAL) site = 13; else if (p >= 1) { const int l = (p - 1) / 12, j = (p - 1) % 12; site = (j <= 6) ? j + 1 : ((l & 1) == 0 ? j + 1 : (j == 7 ? 10 : (j == 8 ? 11 : 12))); }
        for (int rep = 0; rep < 1 + ((HOSTDBL >> site) & 1); ++rep) {
            switch (site) {
#define LSITE(k) case k: hipLaunchKernelGGL(mega<(1 << k)>, dim3(grid), dim3(NTHR), LDS_BYTES, stream, a); break;
                LSITE(14) LSITE(0) LSITE(1) LSITE(2) LSITE(3) LSITE(4) LSITE(5) LSITE(6) LSITE(7) LSITE(8) LSITE(9) LSITE(10) LSITE(11) LSITE(12) LSITE(13)
#undef LSITE
            } }
    }
#ifdef DBG_CUT
    hipLaunchKernelGGL(dbg_dump, dim3(2048), dim3(256), 0, stream, (const bf16*)((const char*)d_ws + DBG_SRC), (size_t)DBG_N, (float*)d_out, (size_t)out_size);
#endif
#endif
}
```

```cpp
#include <hip/hip_runtime.h>
#include <cstdio>
#include <cstdint>

#ifndef MK_ONE_LAUNCH
#define MK_ONE_LAUNCH 1
#endif

#define LAS __attribute__((address_space(3)))
typedef unsigned short bf16;
typedef short bf16x8 __attribute__((ext_vector_type(8)));
typedef float f32x4 __attribute__((ext_vector_type(4)));
typedef float f32x2 __attribute__((ext_vector_type(2)));
typedef unsigned u32x4 __attribute__((ext_vector_type(4)));
typedef unsigned u32x2 __attribute__((ext_vector_type(2)));

constexpr int NB = 8, SEQ = 8192, D = 1024, LC = 256, DEPTH = 4;
constexpr int NCTX = NB * LC;
constexpr int NLAT = NB * SEQ;
constexpr int NTOK = NCTX + NLAT;
constexpr int DH = 512, NH = 4;
constexpr int DIN = 3072, ZW = 1536;
constexpr int DFF = 2816, DFE = 3584, NE = 8;
constexpr int NCHUNK = 132;
constexpr int NUNIT_P0 = NB * NH * 2 * NCHUNK;
constexpr float EPS = 1e-6f;
constexpr float QSCALE = 0.08838834764831845f;
constexpr int MOE_TILES_CAP = 272;
constexpr int NTHR = 512;

constexpr size_t MiB = (size_t)1 << 20;
constexpr size_t WS_CTL = 0, CTL_BYTES = 1 * MiB;
constexpr size_t WS_MODS = 1 * MiB;
constexpr size_t WS_LB = 2 * MiB;
constexpr size_t WS_META = 2 * MiB + 65536;
constexpr size_t WS_RS = 2 * MiB + 131072;
constexpr size_t WS_SRS = 6 * MiB;
constexpr size_t WS_ROUTE = 3 * MiB;
constexpr size_t WS_LIST = 5 * MiB;
constexpr size_t WS_HCTX = 8 * MiB;
constexpr size_t WS_HL0 = 148 * MiB;
constexpr size_t WS_HL1 = 1011 * MiB;
constexpr size_t WS_WIN = 16 * MiB;
constexpr size_t WS_WOUT = 40 * MiB;
constexpr size_t WS_WF1 = 48 * MiB;
constexpr size_t WS_WF2 = 70 * MiB;
constexpr size_t WS_R1 = 82 * MiB;
constexpr size_t WS_BIG = 214 * MiB;
constexpr size_t WS_ZA = WS_BIG;
constexpr size_t WS_ZB = WS_BIG + 198 * MiB;
constexpr size_t WS_QF = WS_BIG + 396 * MiB;
constexpr size_t WS_KF = WS_QF + 132 * MiB;
constexpr size_t WS_AF = WS_KF + 132 * MiB;
constexpr size_t WS_VF = WS_AF + 66 * MiB;
constexpr size_t WS_DEC = WS_VF + 66 * MiB;
constexpr size_t WS_POOL1 = WS_ZA + 132 * MiB;
constexpr size_t WS_ACT = WS_BIG;
constexpr size_t WS_YB = WS_BIG + 476 * MiB;
constexpr size_t WS_WM1 = 1075 * MiB;
constexpr size_t WS_WM2 = WS_WM1 + 56 * MiB;
constexpr size_t WS_END = WS_WM2 + 28 * MiB;
static_assert(WS_DEC + 5 * MiB <= WS_HL1 && WS_HL1 + 64 * MiB <= WS_WM1 && WS_POOL1 + 64 * MiB <= WS_ZB && WS_R1 + 66 * MiB <= WS_HL0 && WS_HL0 + 64 * MiB <= WS_BIG, "ws map");
static_assert(WS_END == 1159 * MiB && WS_YB + 264 * MiB <= WS_WM1 && WS_YB >= WS_ACT + 476 * MiB, "ws map");

constexpr int LDS_BYTES = 147456;
constexpr int LDS_MISC = LDS_BYTES - 256;

typedef __bf16 bf16x2_t __attribute__((ext_vector_type(2)));
__device__ __forceinline__ unsigned pk2(float lo, float hi) { const f32x2 v = {lo, hi}; const bf16x2_t b = __builtin_convertvector(v, bf16x2_t); return __builtin_bit_cast(unsigned, b); }
__device__ __forceinline__ unsigned pk4_i8(float a, float b, float c, float d) {
    const float M = 12582912.0f;
    const unsigned ua = __builtin_bit_cast(unsigned, __builtin_amdgcn_fmed3f(a, -127.f, 127.f) + M), ub = __builtin_bit_cast(unsigned, __builtin_amdgcn_fmed3f(b, -127.f, 127.f) + M);
    const unsigned uc = __builtin_bit_cast(unsigned, __builtin_amdgcn_fmed3f(c, -127.f, 127.f) + M), ud = __builtin_bit_cast(unsigned, __builtin_amdgcn_fmed3f(d, -127.f, 127.f) + M);
    return __builtin_amdgcn_perm(ub, ua, 0x0c0c0400u) | __builtin_amdgcn_perm(ud, uc, 0x04000c0cu); }
constexpr float Q_SA = 127.f / 8.f, Q_SW1 = 127.f / 0.1406250f, Q_SW2 = 127.f / 0.0751671f, Q_SW2D = 127.f / 0.0847998f;
__device__ __forceinline__ bf16* hlat_row(unsigned char* ws, int rr) { return (bf16*)(ws + (rr < 32768 ? WS_HL0 : WS_HL1)) + (size_t)(rr & 32767) * D; }
__device__ __forceinline__ bf16 f2bf(float x) { return (bf16)(pk2(x, 0.f) & 0xffffu); }
__device__ __forceinline__ float bf2f(bf16 x) { return __uint_as_float(((unsigned)x) << 16); }
__device__ __forceinline__ float bflo(unsigned w) { return __uint_as_float(w << 16); }
__device__ __forceinline__ float bfhi(unsigned w) { return __uint_as_float(w & 0xffff0000u); }
__device__ __forceinline__ float siluf(float x) { return x * __builtin_amdgcn_rcpf(1.0f + __expf(-x)); }
#define DPP_F(v, ctrl) __builtin_bit_cast(float, __builtin_amdgcn_update_dpp(0, __builtin_bit_cast(int, (v)), (ctrl), 0xf, 0xf, false))
__device__ __forceinline__ float row16_sum(float v) {
    v += DPP_F(v, 0xB1);
    v += DPP_F(v, 0x4E);
    v += DPP_F(v, 0x124);
    v += DPP_F(v, 0x128);
    return v; }
__device__ __forceinline__ float wave_max(float v) {
    v = fmaxf(v, DPP_F(v, 0xB1)); v = fmaxf(v, DPP_F(v, 0x4E)); v = fmaxf(v, DPP_F(v, 0x124)); v = fmaxf(v, DPP_F(v, 0x128));
    const int i = __builtin_bit_cast(int, v);
    return fmaxf(fmaxf(__builtin_bit_cast(float, __builtin_amdgcn_readlane(i, 0)), __builtin_bit_cast(float, __builtin_amdgcn_readlane(i, 16))), fmaxf(__builtin_bit_cast(float, __builtin_amdgcn_readlane(i, 32)), __builtin_bit_cast(float, __builtin_amdgcn_readlane(i, 48)))); }
__device__ __forceinline__ float wave_sum(float v) {
    v = row16_sum(v);
    const int i = __builtin_bit_cast(int, v);
    return __builtin_bit_cast(float, __builtin_amdgcn_readlane(i, 0)) + __builtin_bit_cast(float, __builtin_amdgcn_readlane(i, 16)) + __builtin_bit_cast(float, __builtin_amdgcn_readlane(i, 32)) + __builtin_bit_cast(float, __builtin_amdgcn_readlane(i, 48)); }

#define XB_TMO      128
#define XB_XCNT(j)  (256  + 64 * (j))
#define XB_XSUB(j)  (1280 + 64 * (j))
#define XB_XGEN(j)  (2304 + 64 * (j))
#define XB_TOP      3328
#define XB_TOPGEN   3392
#define XCD_BAR_WORDS 3456
#define XB_SPIN_CAP (1u << 18)
#define LAS __attribute__((address_space(3)))

__device__ __forceinline__ unsigned xb_ld(unsigned* p)              { return __hip_atomic_load(p, __ATOMIC_RELAXED, __HIP_MEMORY_SCOPE_AGENT); }
__device__ __forceinline__ unsigned xb_add(unsigned* p, unsigned v) { return __hip_atomic_fetch_add(p, v, __ATOMIC_RELAXED, __HIP_MEMORY_SCOPE_AGENT); }
__device__ __forceinline__ unsigned xb_xcc_id() { return (unsigned)__builtin_amdgcn_s_getreg((3 << 11) | 20) & 0xFu; }
#define XB_SPIN(cond, bar) do { unsigned _sp = 0; while (cond) { __builtin_amdgcn_s_sleep(1); \
    if ((++_sp & 255u) == 0u) { if (xb_ld(&(bar)[XB_TMO])) break; if (_sp > XB_SPIN_CAP) { atomicAdd(&(bar)[XB_TMO], 1u); break; } } } } while (0)

struct XcdBarrier {
    unsigned* bar; unsigned x;
    volatile LAS unsigned* st;
};

__device__ __forceinline__ XcdBarrier xcd_barrier_post(unsigned* bar, volatile LAS unsigned* st) {
    XcdBarrier b; b.bar = bar; b.x = xb_xcc_id(); b.st = st;
    if (threadIdx.x == 0) (void)xb_add(&bar[XB_XCNT(b.x)], 1u);
    return b;
}
__device__ __forceinline__ void xcd_barrier_complete(unsigned* bar, unsigned x, unsigned& nloc, unsigned& nx) {
    const unsigned G = gridDim.x * gridDim.y * gridDim.z;
    unsigned sum, cnt, mine, sp = 0u;
    for (;;) {
        sum = 0u; cnt = 0u; mine = 0u;
#pragma unroll
        for (unsigned j = 0; j < 16; ++j) { const unsigned c = xb_ld(&bar[XB_XCNT(j)]); sum += c; cnt += (c > 0u) ? 1u : 0u; mine = (j == x) ? c : mine; }
        if (sum == G) break;
        __builtin_amdgcn_s_sleep(1);
        if ((++sp & 255u) == 0u) { if (xb_ld(&bar[XB_TMO])) break; if (sp > XB_SPIN_CAP) { atomicAdd(&bar[XB_TMO], 1u); break; } }
    }
    nloc = mine > 0u ? mine : 1u; nx = cnt > 0u ? cnt : 1u;
}

__device__ __forceinline__ void xcd_barrier(const XcdBarrier& b) {
    asm volatile("s_waitcnt vmcnt(0)" ::: "memory");
    __syncthreads();
    if (threadIdx.x == 0) {
        unsigned* bar = b.bar;
        __builtin_amdgcn_s_waitcnt(0);
        unsigned nloc = b.st[0], nx = b.st[1];
        if (nloc == 0u) { xcd_barrier_complete(bar, b.x, nloc, nx); b.st[0] = nloc; b.st[1] = nx; }
        const unsigned old = xb_add(&bar[XB_XSUB(b.x)], 1u);
        const unsigned gen = old / nloc;
        if (old + 1u == (gen + 1u) * nloc) {
            __builtin_amdgcn_fence(__ATOMIC_RELEASE, "agent");
            asm volatile("s_waitcnt vmcnt(0)" ::: "memory");
            const unsigned og = xb_add(&bar[XB_TOP], 1u);
            const unsigned tg = og / nx;
            if (og + 1u == (tg + 1u) * nx) xb_add(&bar[XB_TOPGEN], 1u);
            else XB_SPIN(xb_ld(&bar[XB_TOPGEN]) == tg, bar);
            __builtin_amdgcn_fence(__ATOMIC_ACQUIRE, "agent");
            xb_add(&bar[XB_XGEN(b.x)], 1u);
            asm volatile("s_waitcnt vmcnt(0)" ::: "memory");
        } else {
            XB_SPIN(xb_ld(&bar[XB_XGEN(b.x)]) == gen, bar);
            __builtin_amdgcn_fence(__ATOMIC_ACQUIRE, "agent");
            asm volatile("s_waitcnt vmcnt(0)" ::: "memory");
        }
    }
    __syncthreads();
}


namespace pg8 {
typedef int i32x4 __attribute__((ext_vector_type(4)));
template <bool I8> struct AccSel { typedef f32x4 T; };
template <> struct AccSel<true> { typedef i32x4 T; };
constexpr int BM = 256, BK = 64, HALF = 128, HTB = HALF * BK * 2, STAGE_BYTES = 8 * HTB, NXCD = 8, WGM = 8;
__device__ __forceinline__ int lds_byte(int r, int c) { const int st = (r >> 4) * 2 + (c >> 5), rr = r & 15, cc = c & 31, ob = rr * 64 + cc * 2; return st * 1024 + (ob ^ (((ob >> 9) & 1) << 5)); }
__device__ __forceinline__ void stage_rc(int b, int& R, int& C) { const int st = b / 1024, sb = b % 1024, swz = sb ^ (((sb >> 9) & 1) << 5); R = (st >> 1) * 16 + swz / 64; C = (st & 1) * 32 + (swz % 64) / 2; }
__device__ __forceinline__ int perm32(int rho) { const int n = rho >> 4, i = rho & 15; return 8 * (i >> 2) + 4 * n + (i & 3); }

struct Unit { int pm, pn; };

struct StaticOrder {
    int nM, nN, nwg, G, c;
    __device__ void init(int nM_, int nN_, int G_, int c_) { nM = nM_; nN = nN_; nwg = nM * nN; G = G_; c = c_; }
    __device__ bool next(int i, Unit& u) const {
        const long L = (long)i * G + c; if (L >= nwg) return false;
        int wgid = (int)L; { const int q = nwg / NXCD, r = nwg % NXCD, xcd = wgid % NXCD, off = wgid / NXCD; wgid = (xcd < r ? xcd * (q + 1) : r * (q + 1) + (xcd - r) * q) + off; }
        const int nig = WGM * nN, gid = wgid / nig, fm = gid * WGM, gsz = (nM - fm) < WGM ? (nM - fm) : WGM;
        u.pm = fm + ((wgid % nig) % gsz); u.pn = (wgid % nig) / gsz; return true;
    }
};
struct MoeOrder {
    StaticOrder so; const int* tbase; int nNt;
    __device__ void init(const int* tb, int nNt_, int G_, int c_) { tbase = tb; nNt = nNt_; so.init(tb[8], nNt_, G_, c_); }
    __device__ bool next(int i, Unit& u) const {
        if (!so.next(i, u)) return false;
        int e = 0;
#pragma unroll
        for (int j = 1; j < 8; ++j) e += (u.pm >= tbase[j]) ? 1 : 0;
        u.pn += e * nNt; return true;
    }
};

struct EpiBf16 {
    bf16* O; int ldc; int tps; size_t split_stride;
    __device__ __forceinline__ void operator()(const f32x4 (&acc)[2][2][4][2], const Unit& u, int wr, int wc, int fr, int fq) const {
        const int row0 = u.pm * BM + wr * 64 + fr; const int t = u.pn / tps; bf16* base = O + (size_t)t * split_stride;
        const int col0 = (u.pn - t * tps) * BM + wc * 32 + 8 * fq;
#pragma unroll
        for (int ai = 0; ai < 2; ++ai)
#pragma unroll
            for (int m = 0; m < 4; ++m) { bf16* rowp = base + (size_t)(row0 + ai * HALF + m * 16) * ldc + col0;
#pragma unroll
                for (int bj = 0; bj < 2; ++bj) { const f32x4 v0 = acc[ai][bj][m][0], v1 = acc[ai][bj][m][1];
                    u32x4 w; w.x = pk2(v0[0], v0[1]); w.y = pk2(v0[2], v0[3]); w.z = pk2(v1[0], v1[1]); w.w = pk2(v1[2], v1[3]);
                    *(u32x4*)(rowp + bj * HALF) = w; } }
    }
};
struct EpiSwiGLU {
    bf16* O; int ldc; int nNt;
    __device__ __forceinline__ void operator()(const f32x4 (&acc)[2][2][4][2], const Unit& u, int wr, int wc, int fr, int fq) const {
        const int row0 = u.pm * BM + wr * 64 + fr; const int col0 = (u.pn % nNt) * HALF + wc * 32 + 8 * fq;
#pragma unroll
        for (int ai = 0; ai < 2; ++ai)
#pragma unroll
            for (int m = 0; m < 4; ++m) { bf16* rowp = O + (size_t)(row0 + ai * HALF + m * 16) * ldc + col0;
                float r[8];
#pragma unroll
                for (int n = 0; n < 2; ++n)
#pragma unroll
                    for (int j = 0; j < 4; ++j) { const float g = acc[ai][0][m][n][j], up = acc[ai][1][m][n][j]; r[n * 4 + j] = siluf(g) * up; }
                u32x4 w; w.x = pk2(r[0], r[1]); w.y = pk2(r[2], r[3]); w.z = pk2(r[4], r[5]); w.w = pk2(r[6], r[7]);
                *(u32x4*)rowp = w; }
    }
};
struct EpiZQ {
    bf16* O; int ldc; int tps; size_t split_stride; const float* rs; float inv_w;
    __device__ __forceinline__ void operator()(const i32x4 (&acc)[2][2][4][2], const Unit& u, int wr, int wc, int fr, int fq) const {
        const int row0 = u.pm * BM + wr * 64 + fr; const int t = u.pn / tps; bf16* base = O + (size_t)t * split_stride;
        const int col0 = (u.pn - t * tps) * BM + wc * 32 + 8 * fq;
        float rsv[2][4];
#pragma unroll
        for (int ai = 0; ai < 2; ++ai)
#pragma unroll
            for (int m = 0; m < 4; ++m) rsv[ai][m] = rs[row0 + ai * HALF + m * 16];
#pragma unroll
        for (int ai = 0; ai < 2; ++ai)
#pragma unroll
            for (int m = 0; m < 4; ++m) { const int r = row0 + ai * HALF + m * 16; bf16* rowp = base + (size_t)r * ldc + col0; const float s = rsv[ai][m] * inv_w;
#pragma unroll
                for (int bj = 0; bj < 2; ++bj) { const f32x4 v0 = __builtin_convertvector(acc[ai][bj][m][0], f32x4) * s, v1 = __builtin_convertvector(acc[ai][bj][m][1], f32x4) * s;
                    u32x4 w; w.x = pk2(v0[0], v0[1]); w.y = pk2(v0[2], v0[3]); w.z = pk2(v1[0], v1[1]); w.w = pk2(v1[2], v1[3]);
                    *(u32x4*)(rowp + bj * HALF) = w; } }
    }
};
struct EpiSwiGLUQ {
    unsigned char* O; int ldc; int nNt; const float* rs; float inv_w, s_out;
    __device__ __forceinline__ void operator()(const i32x4 (&acc)[2][2][4][2], const Unit& u, int wr, int wc, int fr, int fq) const {
        const int row0 = u.pm * BM + wr * 64 + fr; const int col0 = (u.pn % nNt) * HALF + wc * 32 + 8 * fq;
        float rsv[2][4];
#pragma unroll
        for (int ai = 0; ai < 2; ++ai)
#pragma unroll
            for (int m = 0; m < 4; ++m) rsv[ai][m] = rs[row0 + ai * HALF + m * 16];
#pragma unroll
        for (int ai = 0; ai < 2; ++ai)
#pragma unroll
            for (int m = 0; m < 4; ++m) { unsigned char* rowp = O + (size_t)(row0 + ai * HALF + m * 16) * ldc + col0; const float inv_in = rsv[ai][m] * inv_w;
                const float c1 = inv_in * -1.44269504f, c2 = inv_in * inv_in * s_out;
                float r[8];
#pragma unroll
                for (int n = 0; n < 2; ++n)
#pragma unroll
                    for (int j = 0; j < 4; ++j) { const float fg = (float)acc[ai][0][m][n][j], fu = (float)acc[ai][1][m][n][j];
                        r[n * 4 + j] = (fg * fu) * c2 * __builtin_amdgcn_rcpf(1.0f + __builtin_amdgcn_exp2f(fg * c1)); }
                u32x2 w; w.x = pk4_i8(r[0], r[1], r[2], r[3]); w.y = pk4_i8(r[4], r[5], r[6], r[7]);
                *(u32x2*)rowp = w; }
    }
};
struct EpiResid {
    unsigned char* ws; const float* in0_ctx; const float* in0_lat; const float* gate; int row_off; float sc; const float* rs;
    template <class AT> __device__ __forceinline__ void operator()(const AT (&acc)[2][2][4][2], const Unit& u, int wr, int wc, int fr, int fq) const {
        const int grow0 = row_off + u.pm * BM; const bool isctx = grow0 < NCTX; const int b = isctx ? 8 : ((grow0 - NCTX) >> 13);
        bf16* hb = isctx ? (bf16*)(ws + WS_HCTX) + (size_t)grow0 * D : hlat_row(ws, grow0 - NCTX);
        const float* hin = isctx ? in0_ctx + (size_t)grow0 * D : in0_lat + (size_t)(grow0 - NCTX) * D;
        const bool first = in0_lat != nullptr;
        const int col0 = u.pn * BM + wc * 32 + 8 * fq;
        f32x4 gv[2][2];
#pragma unroll
        for (int bj = 0; bj < 2; ++bj)
#pragma unroll
            for (int n = 0; n < 2; ++n) gv[bj][n] = *(const f32x4*)(gate + (size_t)b * 6144 + col0 + bj * HALF + 4 * n) * sc;
        float rsa[2][4];
#pragma unroll
        for (int ai = 0; ai < 2; ++ai)
#pragma unroll
            for (int m = 0; m < 4; ++m) rsa[ai][m] = rs ? rs[grow0 + wr * 64 + fr + ai * HALF + m * 16] : 1.0f;
#pragma unroll
        for (int ai = 0; ai < 2; ++ai)
#pragma unroll
            for (int m = 0; m < 4; ++m) { const int rl = wr * 64 + fr + ai * HALF + m * 16; const size_t ro = (size_t)rl * D + col0; const float rsv = rsa[ai][m];
#pragma unroll
                for (int bj = 0; bj < 2; ++bj) { f32x4 h0, h1;
                    if (first) { h0 = *(const f32x4*)(hin + ro + bj * HALF); h1 = *(const f32x4*)(hin + ro + bj * HALF + 4); }
                    else { const u32x4 hw = *(const u32x4*)(hb + ro + bj * HALF); h0 = (f32x4){bflo(hw.x), bfhi(hw.x), bflo(hw.y), bfhi(hw.y)}; h1 = (f32x4){bflo(hw.z), bfhi(hw.z), bflo(hw.w), bfhi(hw.w)}; }
                    h0 += gv[bj][0] * (__builtin_convertvector(acc[ai][bj][m][0], f32x4) * rsv); h1 += gv[bj][1] * (__builtin_convertvector(acc[ai][bj][m][1], f32x4) * rsv);
                    u32x4 w; w.x = pk2(h0[0], h0[1]); w.y = pk2(h0[2], h0[3]); w.z = pk2(h1[0], h1[1]); w.w = pk2(h1[2], h1[3]);
                    *(u32x4*)(hb + ro + bj * HALF) = w; } }
    }
};
struct EpiScatter {
    bf16* YB; const int* list; int nNt; float sc;
    template <class AT> __device__ __forceinline__ void operator()(const AT (&acc)[2][2][4][2], const Unit& u, int wr, int wc, int fr, int fq) const {
        const int row0 = u.pm * BM + wr * 64 + fr; const int col0 = (u.pn % nNt) * BM + wc * 32 + 8 * fq;
#pragma unroll
        for (int ai = 0; ai < 2; ++ai)
#pragma unroll
            for (int m = 0; m < 4; ++m) { const int ent = list[row0 + ai * HALF + m * 16];
                if (ent >= 0) { bf16* rowp = YB + ((size_t)(ent & 1) * NTOK + (size_t)(ent >> 1)) * D + col0;
#pragma unroll
                    for (int bj = 0; bj < 2; ++bj) { const f32x4 v0 = __builtin_convertvector(acc[ai][bj][m][0], f32x4) * sc, v1 = __builtin_convertvector(acc[ai][bj][m][1], f32x4) * sc;
                        u32x4 w; w.x = pk2(v0[0], v0[1]); w.y = pk2(v0[2], v0[3]); w.z = pk2(v1[0], v1[1]); w.w = pk2(v1[2], v1[3]);
                        *(u32x4*)(rowp + bj * HALF) = w; } }
                asm volatile("" ::: "memory"); }
    }
};

template <class Epi, class Sched, bool GATHER, bool I8 = false>
__device__ __forceinline__ void gemm_phase(LAS unsigned char* lds, const bf16* A, const bf16* Bt, const int K, const Sched& S, const Epi& E, const int* glist) {
    int tid_ = threadIdx.x; asm volatile("" : "+v"(tid_));
    const int tid = tid_, wid = __builtin_amdgcn_readfirstlane(tid >> 6), lane = tid & 63, wr = wid >> 2, wc = wid & 3, fr = lane & 15, fq = lane >> 4;
    const int nt = K / BK;
    int RA0, CA0; stage_rc(tid * 16, RA0, CA0);
    const unsigned voffA0 = (unsigned)(RA0 * K + CA0) * 2u, voffB0 = (unsigned)(((RA0 & ~31) + perm32(RA0 & 31)) * K + CA0) * 2u;
    const unsigned pstep = 64u * (unsigned)K * 2u, kstep = (unsigned)BK * 2u, hstep = (unsigned)HALF * (unsigned)K * 2u, tstep = 2u * hstep;
    const unsigned ldsw = (unsigned)wid * 1024u;
    const int aoff = lds_byte(wr * 64 + fr, fq * 8), boff = lds_byte(wc * 32 + fr, fq * 8);
    unsigned gA[2][2];
#define PG8_GOFF(dst, u) do { _Pragma("unroll") for (int _h = 0; _h < 2; ++_h) _Pragma("unroll") for (int _i = 0; _i < 2; ++_i) { \
        const int _e = glist[(u).pm * BM + _h * HALF + _i * 64 + RA0]; const int _r = _e < 0 ? 0 : (_e >> 1); dst[_h][_i] = (unsigned)(_r * K + CA0) * 2u; } } while (0)
#define PG8_SA(b, h) (((b) * 2 + (h)) * HTB)
#define PG8_SB(b, h) ((4 + (b) * 2 + (h)) * HTB)
#define PG8_LD(ldsoff, base, off32) __builtin_amdgcn_global_load_lds((const unsigned*)((const char*)(base) + (size_t)(unsigned)(off32)), (LAS unsigned*)(lds + (ldsoff) + ldsw), 16, 0, 0)
#define PG8_STAGE_B(bufoff, soff) do { _Pragma("unroll") for (int _i = 0; _i < 2; ++_i) PG8_LD((bufoff) + _i * 8192, Bt, voffB0 + ((soff) + _i * pstep)); } while (0)
#define PG8_STAGE_A(bufoff, soff, kb, h, nx) do { if constexpr (GATHER) { _Pragma("unroll") for (int _i = 0; _i < 2; ++_i) PG8_LD((bufoff) + _i * 8192, A, gA[h][_i] + (kb)); } \
        else { _Pragma("unroll") for (int _i = 0; _i < 2; ++_i) PG8_LD((bufoff) + _i * 8192, A, voffA0 + ((soff) + (kb) + (h) * hstep + _i * pstep)); } } while (0)
#define PG8_LDA(dst, b, h) do { _Pragma("unroll") for (int m = 0; m < 4; ++m) _Pragma("unroll") for (int k = 0; k < 2; ++k) dst[m][k] = *(const LAS bf16x8*)(lds + PG8_SA(b, h) + aoff + m * 2048 + k * 1024); } while (0)
#define PG8_LDB(dst, b, h) do { _Pragma("unroll") for (int n = 0; n < 2; ++n) _Pragma("unroll") for (int k = 0; k < 2; ++k) dst[n][k] = *(const LAS bf16x8*)(lds + PG8_SB(b, h) + boff + n * 2048 + k * 1024); } while (0)
#define PG8_MMA(ai, bj, At, Bt_) do { __builtin_amdgcn_s_setprio(1); _Pragma("unroll") for (int m = 0; m < 4; ++m) _Pragma("unroll") for (int n = 0; n < 2; ++n) _Pragma("unroll") for (int k = 0; k < 2; ++k) { \
            if constexpr (I8) acc[ai][bj][m][n] = __builtin_amdgcn_mfma_i32_16x16x64_i8(__builtin_bit_cast(i32x4, Bt_[n][k]), __builtin_bit_cast(i32x4, At[m][k]), acc[ai][bj][m][n], 0, 0, 0); \
            else acc[ai][bj][m][n] = __builtin_amdgcn_mfma_f32_16x16x32_bf16(Bt_[n][k], At[m][k], acc[ai][bj][m][n], 0, 0, 0); } \
        __builtin_amdgcn_s_setprio(0); } while (0)
#define PG8_WAIT_V(n) asm volatile("s_waitcnt vmcnt(" #n ")" ::: "memory")
#define PG8_WAIT_L(n) asm volatile("s_waitcnt lgkmcnt(" #n ")" ::: "memory")
#define PG8_BAR __builtin_amdgcn_s_barrier()
#define PG8_SCHED __builtin_amdgcn_sched_barrier(0)
    Unit cur, nxt; int ui = 0;
    if (!S.next(0, cur)) return;
    typedef typename AccSel<I8>::T AccT;
    AccT acc[2][2][4][2];
#pragma unroll
    for (int a = 0; a < 2; ++a)
#pragma unroll
        for (int b = 0; b < 2; ++b)
#pragma unroll
            for (int m = 0; m < 4; ++m)
#pragma unroll
                for (int n = 0; n < 2; ++n) acc[a][b][m][n] = (AccT){0, 0, 0, 0};
    bf16x8 At[4][2], B0[2][2], B1[2][2];

    unsigned uA = GATHER ? 0u : (unsigned)cur.pm * tstep, uB = (unsigned)cur.pn * tstep;
    if constexpr (GATHER) { PG8_GOFF(gA, cur); }
    PG8_STAGE_B(PG8_SB(0, 0), uB); PG8_STAGE_B(PG8_SB(0, 1), uB + hstep); PG8_STAGE_A(PG8_SA(0, 0), uA, 0u, 0, false); PG8_STAGE_A(PG8_SA(0, 1), uA, 0u, 1, false);
    if (wr == 1) PG8_BAR;
    PG8_WAIT_V(2); PG8_BAR;
    PG8_STAGE_B(PG8_SB(1, 0), uB + kstep); PG8_STAGE_A(PG8_SA(1, 0), uA, kstep, 0, false); PG8_STAGE_B(PG8_SB(1, 1), uB + hstep + kstep);
    PG8_WAIT_V(6); PG8_BAR;
    for (;;) {
        const bool has_next = S.next(ui + 1, nxt);
        const unsigned nuA = (has_next && !GATHER) ? (unsigned)nxt.pm * tstep : uA, nuB = has_next ? (unsigned)nxt.pn * tstep : uB;
        _Pragma("nounroll") for (int t = 0; t < nt; t += 2) {
            const bool last = (t == nt - 2);
            const unsigned k1 = (unsigned)(t + 1) * kstep, k2 = last ? 0u : (unsigned)(t + 2) * kstep, k3 = k2 + kstep;
            const unsigned a2 = last ? nuA : uA, b2 = (last ? nuB : uB) + k2, b3 = b2 + kstep;
            unsigned gN[2][2];
            if constexpr (GATHER) { if (last && has_next) { PG8_GOFF(gN, nxt); } else {
#pragma unroll
                for (int _h = 0; _h < 2; ++_h)
#pragma unroll
                    for (int _i = 0; _i < 2; ++_i) gN[_h][_i] = gA[_h][_i]; } }
            PG8_LDB(B0, 0, 0); PG8_LDB(B1, 0, 1); PG8_SCHED; PG8_LDA(At, 0, 0); PG8_STAGE_A(PG8_SA(1, 1), uA, k1, 1, false);
            PG8_WAIT_V(8); PG8_WAIT_L(0); PG8_BAR; PG8_MMA(0, 0, At, B0); PG8_MMA(0, 1, At, B1); PG8_BAR; PG8_SCHED;
            if constexpr (GATHER) {
#pragma unroll
                for (int _h = 0; _h < 2; ++_h)
#pragma unroll
                    for (int _i = 0; _i < 2; ++_i) gA[_h][_i] = gN[_h][_i]; }
            PG8_LDA(At, 0, 1); PG8_STAGE_B(PG8_SB(0, 0), b2); PG8_STAGE_B(PG8_SB(0, 1), b2 + hstep); PG8_STAGE_A(PG8_SA(0, 0), a2, k2, 0, last);
            PG8_WAIT_V(8); PG8_WAIT_L(0); PG8_BAR; PG8_MMA(1, 0, At, B0); PG8_MMA(1, 1, At, B1); PG8_BAR; PG8_SCHED;
            PG8_LDB(B0, 1, 0); PG8_LDB(B1, 1, 1); PG8_SCHED; PG8_LDA(At, 1, 0); PG8_STAGE_A(PG8_SA(0, 1), a2, k2, 1, last);
            PG8_WAIT_V(8); PG8_WAIT_L(0); PG8_BAR; PG8_MMA(0, 0, At, B0); PG8_MMA(0, 1, At, B1); PG8_BAR; PG8_SCHED;
            PG8_LDA(At, 1, 1); PG8_STAGE_B(PG8_SB(1, 0), b3); PG8_STAGE_B(PG8_SB(1, 1), b3 + hstep); PG8_STAGE_A(PG8_SA(1, 0), a2, k3, 0, last);
            PG8_WAIT_V(8); PG8_WAIT_L(0); PG8_BAR; PG8_MMA(1, 0, At, B0); PG8_MMA(1, 1, At, B1); PG8_BAR; PG8_SCHED;
        }
        if (wr == 0) PG8_BAR;
        E(acc, cur, wr, wc, fr, fq);
        if (!has_next) break;
#pragma unroll
        for (int a = 0; a < 2; ++a)
#pragma unroll
            for (int b = 0; b < 2; ++b)
#pragma unroll
                for (int m = 0; m < 4; ++m)
#pragma unroll
                    for (int n = 0; n < 2; ++n) acc[a][b][m][n] = (AccT){0, 0, 0, 0};
        cur = nxt; uA = nuA; uB = nuB; ++ui;
        if (wr == 1) PG8_BAR;
    }
    PG8_WAIT_V(0);
    PG8_BAR;
#undef PG8_GOFF
#undef PG8_SA
#undef PG8_SB
#undef PG8_LD
#undef PG8_STAGE_B
#undef PG8_STAGE_A
#undef PG8_LDA
#undef PG8_LDB
#undef PG8_MMA
#undef PG8_WAIT_V
#undef PG8_WAIT_L
#undef PG8_BAR
#undef PG8_SCHED
}
}

struct Args { const float* in[21]; float* out; unsigned char* ws; int ph_lo, ph_hi, dbl, pad; };
enum { IN_X = 0, IN_C, IN_CTX, IN_CCTX, IN_WADA, IN_BADA, IN_NORMW, IN_WIN, IN_LBRAW, IN_HNORMW, IN_WPOOL, IN_PSCALE, IN_WOUT, IN_FWG, IN_FWU, IN_FWD, IN_ROUTER, IN_MWG, IN_MWU, IN_MWD, IN_FNW };

struct Frame {
    const Args* a; unsigned char* ws; LAS unsigned char* lds; int tid, lane, wid, G, bid;
};
#define PH_LOCALS(F) int tid = (F).tid; asm volatile("" : "+v"(tid)); const int lane = tid & 63; const int wid = __builtin_amdgcn_readfirstlane(tid >> 6); unsigned char* ws = (F).ws; (void)lane; (void)wid; (void)ws;

#define GAS __attribute__((address_space(1)))
struct WJob { const GAS float* src; bf16* dst; unsigned ld, dld; int k0, n0, drow0, gstride; float qs; };
constexpr int WT_DENSE = 1952, WT_MOE = 5376;
__device__ __forceinline__ WJob wjob(const Args& a, unsigned char* ws, int kind, int mi, int t) {
    WJob j; j.qs = 0.f;
    if (kind == 0) {
        if (t < 896) { const int l = t / 224, r = t % 224;
            if (r < 160) { const int piece = r / 32, q = r % 32, kt = q >> 1, ntile = q & 1;
                const int sc0 = piece == 0 ? 0 : piece == 1 ? 1024 : piece == 2 ? 1536 : piece == 3 ? 512 : 2048;
                j.src = (const GAS float*)a.in[IN_WIN] + (size_t)l * 1024 * 3072; j.ld = 3072; j.k0 = kt * 64; j.n0 = sc0 + ntile * 256;
                j.dst = (bf16*)(ws + WS_WIN + (size_t)l * 3072 * 1024); j.dld = 1024; j.drow0 = piece * 512 + ntile * 256; j.gstride = 128; j.qs = Q_SW1; }
            else { const int q = r - 160, kt = q >> 2, ntile = q & 3;
                j.src = (const GAS float*)a.in[IN_WOUT] + (size_t)l * 1024 * 1024; j.ld = 1024; j.k0 = kt * 64; j.n0 = ntile * 256;
                j.dst = (bf16*)(ws + WS_WOUT + (size_t)l * 1024 * 1024); j.dld = 1024; j.drow0 = j.n0; j.gstride = 128; j.qs = Q_SW1; } }
        else { const int t2 = t - 896, i = t2 / 528, r = t2 % 528;
            if (r < 352) { const int up = r / 176, q = r % 176, kt = q / 11, ntile = q % 11;
                j.src = (const GAS float*)(up ? a.in[IN_FWU] : a.in[IN_FWG]) + (size_t)i * 1024 * DFF; j.ld = DFF; j.k0 = kt * 64; j.n0 = ntile * 256;
                j.dst = (bf16*)(ws + WS_WF1 + (size_t)i * 5632 * 1024); j.dld = 1024; j.drow0 = ntile * 512 + up * 128; j.gstride = 256; j.qs = Q_SW1; }
            else { const int q = r - 352, kt = q >> 2, ntile = q & 3;
                j.src = (const GAS float*)a.in[IN_FWD] + (size_t)i * DFF * 1024; j.ld = 1024; j.k0 = kt * 64; j.n0 = ntile * 256;
                j.dst = (bf16*)(ws + WS_WF2 + (size_t)i * 1024 * DFF); j.dld = DFF; j.drow0 = j.n0; j.gstride = 128; j.qs = Q_SW2D; } }
    } else {
        const int e = t / 672, r = t % 672; const size_t eo = (size_t)(mi * 8 + e) * 1024 * DFE;
        const float* pwg = a.in[IN_MWG]; const float* pwu = a.in[IN_MWU]; const float* pwd = a.in[IN_MWD];
        asm volatile("" : "+s"(pwg)); asm volatile("" : "+s"(pwu)); asm volatile("" : "+s"(pwd));
        if (r < 448) { const int up = r / 224, q = r % 224, kt = q / 14, ntile = q % 14;
            j.src = (const GAS float*)(up ? pwu : pwg) + eo; j.ld = DFE; j.k0 = kt * 64; j.n0 = ntile * 256;
            j.dst = (bf16*)(ws + WS_WM1 + (size_t)e * 7168 * 1024); j.dld = 1024; j.drow0 = ntile * 512 + up * 128; j.gstride = 256; j.qs = Q_SW1; }
        else { const int q = r - 448, kt = q >> 2, ntile = q & 3;
            j.src = (const GAS float*)pwd + eo; j.ld = 1024; j.k0 = kt * 64; j.n0 = ntile * 256;
            j.dst = (bf16*)(ws + WS_WM2 + (size_t)e * 1024 * DFE); j.dld = DFE; j.drow0 = j.n0; j.gstride = 128; j.qs = Q_SW2; }
    }
    return j;
}
__device__ __forceinline__ void wprep_run(const Frame& F, int kind, int mi, int t0, int ntiles, int wk, int nwk) {
    const Args& a = *F.a; PH_LOCALS(F)
    if (wk < 0) return;
    LAS bf16* Tt = (LAS bf16*)F.lds;
    const int kg = tid >> 6, c4 = (tid & 63) * 4;
    f32x4 v[8];
#pragma unroll
    for (int i = 0; i < 8; ++i) v[i] = (f32x4){0.f, 0.f, 0.f, 0.f};
    const int tf = t0 + wk;
    WJob j = wjob(a, ws, kind, mi, tf < ntiles ? tf : t0);
    if (tf < ntiles) {
#pragma unroll
        for (int i = 0; i < 8; ++i) v[i] = *(const GAS f32x4*)(j.src + (size_t)(j.k0 + kg * 8 + i) * j.ld + j.n0 + c4); }
    for (int t = tf; t < ntiles; t += nwk) {
        if (j.qs != 0.f) {
            LAS unsigned char* T8 = (LAS unsigned char*)F.lds;
            const float qs = j.qs;
#pragma unroll
            for (int e = 0; e < 4; ++e) { u32x2 w; w.x = pk4_i8(v[0][e] * qs, v[1][e] * qs, v[2][e] * qs, v[3][e] * qs); w.y = pk4_i8(v[4][e] * qs, v[5][e] * qs, v[6][e] * qs, v[7][e] * qs);
                *(LAS u32x2*)(T8 + (c4 + e) * 72 + kg * 8) = w; }
            __syncthreads();
            const WJob jc = j;
            if (t + nwk < ntiles) { j = wjob(a, ws, kind, mi, t + nwk);
#pragma unroll
                for (int i = 0; i < 8; ++i) v[i] = *(const GAS f32x4*)(j.src + (size_t)(j.k0 + kg * 8 + i) * j.ld + j.n0 + c4); }
            const int n = tid >> 1, kh = tid & 1;
            u32x2 r[4];
#pragma unroll
            for (int q = 0; q < 4; ++q) r[q] = *(const LAS u32x2*)(T8 + n * 72 + kh * 32 + q * 8);
            u32x4* dp = (u32x4*)((unsigned char*)jc.dst + (size_t)(jc.drow0 + (n >> 7) * jc.gstride + (n & 127)) * jc.dld + jc.k0 + kh * 32);
            dp[0] = (u32x4){r[0].x, r[0].y, r[1].x, r[1].y}; dp[1] = (u32x4){r[2].x, r[2].y, r[3].x, r[3].y};
            __syncthreads();
            continue;
        }
#pragma unroll
        for (int e = 0; e < 4; ++e) { u32x4 w; w.x = pk2(v[0][e], v[1][e]); w.y = pk2(v[2][e], v[3][e]); w.z = pk2(v[4][e], v[5][e]); w.w = pk2(v[6][e], v[7][e]);
            *(LAS u32x4*)(Tt + (c4 + e) * 72 + kg * 8) = w; }
        __syncthreads();
        const WJob jc = j;
        if (t + nwk < ntiles) { j = wjob(a, ws, kind, mi, t + nwk);
#pragma unroll
            for (int i = 0; i < 8; ++i) v[i] = *(const GAS f32x4*)(j.src + (size_t)(j.k0 + kg * 8 + i) * j.ld + j.n0 + c4); }
        const int n = tid >> 1, kh = tid & 1;
        u32x4 r[4];
#pragma unroll
        for (int q = 0; q < 4; ++q) r[q] = *(const LAS u32x4*)(Tt + n * 72 + kh * 32 + q * 8);
        u32x4* dp = (u32x4*)(jc.dst + (size_t)(jc.drow0 + (n >> 7) * jc.gstride + (n & 127)) * jc.dld + jc.k0 + kh * 32);
#pragma unroll
        for (int q = 0; q < 4; ++q) dp[q] = r[q];
        __syncthreads();
    }
}

__device__ __forceinline__ void ph_prologue(const Frame& F) {
    const Args& a = *F.a; PH_LOCALS(F)
    {
        LAS float* sl = (LAS float*)F.lds;
        LAS float* red = sl + 9 * 1024;
        for (int i = tid; i < 9 * 1024; i += NTHR) { const int r = i >> 10, k = i & 1023; const float v = r < 8 ? a.in[IN_C][r * 1024 + k] : a.in[IN_CCTX][k]; sl[i] = siluf(v); }
        __syncthreads();
        float* mods = (float*)(ws + WS_MODS);
        for (int u = F.bid; u < 4 * 96; u += F.G) {
            const int l = u / 96, cb = u % 96, cc = tid & 63, ks = tid >> 6;
            const float* w = a.in[IN_WADA] + (size_t)l * 1024 * 6144 + cb * 64 + cc;
            float acc[9];
#pragma unroll
            for (int r = 0; r < 9; ++r) acc[r] = 0.f;
            for (int k = ks * 128; k < ks * 128 + 128; ++k) { const float wv = w[(size_t)k * 6144];
#pragma unroll
                for (int r = 0; r < 9; ++r) acc[r] += sl[r * 1024 + k] * wv; }
#pragma unroll
            for (int r = 0; r < 9; ++r) red[(ks * 64 + cc) * 9 + r] = acc[r];
            __syncthreads();
            for (int i = tid; i < 64 * 9; i += NTHR) { const int c2 = i / 9, r = i % 9; float s = 0.f;
#pragma unroll
                for (int k2 = 0; k2 < 8; ++k2) s += red[(k2 * 64 + c2) * 9 + r];
                mods[(size_t)(l * 9 + r) * 6144 + cb * 64 + c2] = s + a.in[IN_BADA][l * 6144 + cb * 64 + c2]; }
            __syncthreads();
        }
    }
    if (F.bid == 0) {
        float* lb = (float*)(ws + WS_LB);
        for (int i = tid; i < 1024; i += NTHR) {
            const float r0 = a.in[IN_LBRAW][i], r1 = a.in[IN_LBRAW][1024 + i], r2 = a.in[IN_LBRAW][2048 + i], r3 = a.in[IN_LBRAW][3072 + i];
            const float m = fmaxf(fmaxf(r0, r1), fmaxf(r2, r3));
            const float e0 = __expf(r0 - m), e1 = __expf(r1 - m), e2 = __expf(r2 - m), e3 = __expf(r3 - m);
            const float inv = 1.0f / (e0 + e1 + e2 + e3);
            lb[i] = 0.f; lb[1024 + i] = e1 * inv; lb[2048 + i] = (e1 + e2) * inv; lb[3072 + i] = (e1 + e2 + e3) * inv;
        }
    }
    wprep_run(F, 0, 0, 0, WT_DENSE, F.bid, F.G);
    {
        LAS float* Wt = (LAS float*)F.lds;
        LAS float* Wp = Wt + 64 * 128;
        for (int u = F.bid; u < 256; u += F.G) {
            const int l = u >> 6, j = (u >> 4) & 3, kb = u & 15, k0 = kb * 64;
            const float* wi = a.in[IN_WIN] + (size_t)l * 1024 * 3072 + 2560 + j * 128;
            const float* wp = a.in[IN_WPOOL] + (size_t)(l * 4 + j) * 128 * 128;
            for (int i = tid; i < 64 * 32; i += NTHR) { const int k = i >> 5, c4 = (i & 31) * 4; *(LAS f32x4*)(Wt + k * 128 + c4) = *(const f32x4*)(wi + (size_t)(k0 + k) * 3072 + c4); }
            for (int i = tid; i < 128 * 32; i += NTHR) *(LAS f32x4*)(Wp + i * 4) = *(const f32x4*)(wp + i * 4);
            __syncthreads();
            const int k = tid >> 3, d0 = (tid & 7) * 16;
            float acc[16];
#pragma unroll
            for (int e = 0; e < 16; ++e) acc[e] = 0.f;
            for (int c = 0; c < 128; ++c) { const float av = Wt[k * 128 + c];
#pragma unroll
                for (int e4 = 0; e4 < 4; ++e4) { const f32x4 wv = *(const LAS f32x4*)(Wp + c * 128 + d0 + e4 * 4);
                    acc[e4 * 4 + 0] += av * wv[0]; acc[e4 * 4 + 1] += av * wv[1]; acc[e4 * 4 + 2] += av * wv[2]; acc[e4 * 4 + 3] += av * wv[3]; } }
            signed char* dst = (signed char*)(ws + WS_WIN + (size_t)l * 3072 * 1024);
#pragma unroll
            for (int e = 0; e < 16; ++e) { const int dcol = j * 128 + d0 + e; dst[(size_t)(2560 + dcol) * 1024 + k0 + k] = (signed char)(int)__builtin_rintf(fminf(fmaxf(acc[e] * Q_SW1, -127.f), 127.f)); }
            __syncthreads();
        }
    }
}

template <int WHICH>
__device__ __forceinline__ void ph_norm(const Frame& F, int l) {
    const Args& a = *F.a; PH_LOCALS(F)
    const bool router = (WHICH == 1) && (l & 1);
    LAS float* RW = (LAS float*)F.lds;
    if (router) { const float* rw = a.in[IN_ROUTER] + (size_t)(l >> 1) * 1024 * 8;
        for (int s_ = tid; s_ < 2048; s_ += NTHR) { const int col_ = s_ >> 1, hf_ = s_ & 1, i_ = col_ >> 8, ln_ = (col_ & 255) >> 2, j_ = col_ & 3;
            *(LAS f32x4*)(RW + ((((i_ * 4 + j_) * 2 + hf_) * 64 + ln_) * 4)) = *(const f32x4*)(rw + s_ * 4); }
        __syncthreads(); }
    const int row_lo = (WHICH == 0 || (WHICH == 1 && l < 3)) ? 0 : NCTX, nrows = NTOK - row_lo;
    const int nw = F.G * 8, gw = F.bid * 8 + wid, per = (nrows + nw - 1) / nw;
    const int r0 = row_lo + gw * per, r1 = (r0 + per < NTOK) ? r0 + per : NTOK;
    const bool has_add = (WHICH == 2) || (WHICH == 0 && l > 0 && ((l - 1) & 1));
    const bool first = (l == 0) && (WHICH == 0);
    const bool add_moe = has_add;
    const int lg = (WHICH == 0 ? l - 1 : 3), gi = 5;
    const float* mods = (const float*)(ws + WS_MODS);
    const bf16* yb = (const bf16*)(ws + WS_YB);
    float* route = (float*)(ws + WS_ROUTE);
    bf16* uout = (bf16*)(ws + WS_R1);
    bf16* hctx = (bf16*)(ws + WS_HCTX);
    int curb = -1; f32x4 pa[4], psh[4], pg[4];
    int ecnt[8];
#pragma unroll
    for (int e = 0; e < 8; ++e) ecnt[e] = 0;
#pragma unroll
    for (int i = 0; i < 4; ++i) { pa[i] = (f32x4){0.f, 0.f, 0.f, 0.f}; psh[i] = pa[i]; pg[i] = pa[i]; }
#define NORM_SRCF(row_) ((row_) < NCTX ? a.in[IN_CTX] + (size_t)(row_) * D : a.in[IN_X] + (size_t)((row_) - NCTX) * D)
#define NORM_SRCB(row_) ((row_) < NCTX ? hctx + (size_t)(row_) * D : hlat_row(ws, (row_) - NCTX))
#define NORM_LOAD(dst_, row_) do { if (first) { const float* p_ = NORM_SRCF(row_); _Pragma("unroll") for (int i = 0; i < 4; ++i) dst_[i] = *(const f32x4*)(p_ + i * 256 + lane * 4); } \
        else { const bf16* p_ = NORM_SRCB(row_); _Pragma("unroll") for (int i = 0; i < 4; ++i) { const u32x2 w_ = *(const u32x2*)(p_ + i * 256 + lane * 4); dst_[i] = (f32x4){bflo(w_.x), bfhi(w_.x), bflo(w_.y), bfhi(w_.y)}; } } } while (0)
    f32x4 hn[4], hn2[4];
#pragma unroll
    for (int i = 0; i < 4; ++i) { hn[i] = (f32x4){0.f, 0.f, 0.f, 0.f}; hn2[i] = hn[i]; }
    if (r0 < r1) NORM_LOAD(hn, r0);
    if (r0 + 1 < r1) NORM_LOAD(hn2, r0 + 1);
    for (int row = r0; row < r1; ++row) {
        int b; bf16* hd; float* od = a.out;
        if (row < NCTX) { b = 8; hd = hctx + (size_t)row * D; }
        else { const int rr = row - NCTX; b = rr >> 13; hd = hlat_row(ws, rr); od = a.out + (size_t)rr * D; }
        if (b != curb) { curb = b;
#pragma unroll
            for (int i = 0; i < 4; ++i) { const int col = i * 256 + lane * 4;
                if (WHICH < 2) { const f32x4 nwv = *(const f32x4*)(a.in[IN_NORMW] + l * 2048 + WHICH * 1024 + col);
                    const f32x4 sc = *(const f32x4*)(mods + (size_t)(l * 9 + b) * 6144 + (WHICH ? 4 : 1) * 1024 + col);
                    psh[i] = *(const f32x4*)(mods + (size_t)(l * 9 + b) * 6144 + (WHICH ? 3 : 0) * 1024 + col);
                    pa[i] = nwv * (sc + 1.0f); }
                else pa[i] = *(const f32x4*)(a.in[IN_FNW] + col);
                if (has_add) pg[i] = *(const f32x4*)(mods + (size_t)(lg * 9 + b) * 6144 + gi * 1024 + col); } }
        f32x4 h[4];
#pragma unroll
        for (int i = 0; i < 4; ++i) { h[i] = hn[i]; hn[i] = hn2[i]; }
        if (row + 2 < r1) NORM_LOAD(hn2, row + 2);
        if (has_add) {
            if (add_moe) { const float w0 = route[(size_t)row * 4 + 2], w1 = route[(size_t)row * 4 + 3];
#pragma unroll
                for (int i = 0; i < 4; ++i) { const u32x2 y0 = *(const u32x2*)(yb + (size_t)row * D + i * 256 + lane * 4), y1 = *(const u32x2*)(yb + ((size_t)NTOK + row) * D + i * 256 + lane * 4);
                    f32x4 y; y[0] = w0 * bflo(y0.x) + w1 * bflo(y1.x); y[1] = w0 * bfhi(y0.x) + w1 * bfhi(y1.x); y[2] = w0 * bflo(y0.y) + w1 * bflo(y1.y); y[3] = w0 * bfhi(y0.y) + w1 * bfhi(y1.y);
                    h[i] += pg[i] * y; } }
            if (WHICH != 2) {
#pragma unroll
                for (int i = 0; i < 4; ++i) { u32x2 w; w.x = pk2(h[i][0], h[i][1]); w.y = pk2(h[i][2], h[i][3]); *(u32x2*)(hd + i * 256 + lane * 4) = w; } }
        }
        float ss = 0.f;
#pragma unroll
        for (int i = 0; i < 4; ++i) ss += h[i][0] * h[i][0] + h[i][1] * h[i][1] + h[i][2] * h[i][2] + h[i][3] * h[i][3];
        ss = wave_sum(ss);
        const float rstd = rsqrtf(ss * (1.0f / 1024.0f) + EPS);
        f32x4 v[4];
#pragma unroll
        for (int i = 0; i < 4; ++i) v[i] = h[i] * rstd * pa[i] + psh[i];
        if (WHICH == 2) {
#pragma unroll
            for (int i = 0; i < 4; ++i) *(f32x4*)(od + i * 256 + lane * 4) = v[i]; }
        else {
            float am = 0.f;
#pragma unroll
            for (int i = 0; i < 4; ++i) am = fmaxf(am, fmaxf(fmaxf(fabsf(v[i][0]), fabsf(v[i][1])), fmaxf(fabsf(v[i][2]), fabsf(v[i][3]))));
            am = fmaxf(wave_max(am), 1e-20f);
            const float qs = 127.0f / am;
            if (lane == 0) ((float*)(ws + WS_RS))[row] = am * (1.0f / 127.0f);
#pragma unroll
            for (int i = 0; i < 4; ++i) *(unsigned*)((unsigned char*)uout + (size_t)row * D + i * 256 + lane * 4) = pk4_i8(v[i][0] * qs, v[i][1] * qs, v[i][2] * qs, v[i][3] * qs); }
        if (router) {
            float lg8[8];
#pragma unroll
            for (int e = 0; e < 8; ++e) lg8[e] = 0.f;
#pragma unroll
            for (int i = 0; i < 4; ++i)
#pragma unroll
                for (int j = 0; j < 4; ++j) { const f32x4 wa = *(const LAS f32x4*)(RW + (((i * 4 + j) * 2) * 64 + lane) * 4), wb = *(const LAS f32x4*)(RW + (((i * 4 + j) * 2 + 1) * 64 + lane) * 4); const float x = v[i][j];
                    lg8[0] += x * wa[0]; lg8[1] += x * wa[1]; lg8[2] += x * wa[2]; lg8[3] += x * wa[3]; lg8[4] += x * wb[0]; lg8[5] += x * wb[1]; lg8[6] += x * wb[2]; lg8[7] += x * wb[3]; }
            {
                float a4[4], a2[2];
#pragma unroll
                for (int e = 0; e < 4; ++e) { const float mine = (lane & 32) ? lg8[e + 4] : lg8[e], send = (lane & 32) ? lg8[e] : lg8[e + 4]; a4[e] = mine + __shfl_xor(send, 32); }
#pragma unroll
                for (int e = 0; e < 2; ++e) { const float mine = (lane & 16) ? a4[e + 2] : a4[e], send = (lane & 16) ? a4[e] : a4[e + 2]; a2[e] = mine + __shfl_xor(send, 16); }
                float a1 = ((lane & 8) ? a2[1] : a2[0]) + __shfl_xor((lane & 8) ? a2[0] : a2[1], 8);
                a1 += __shfl_xor(a1, 4); a1 += __shfl_xor(a1, 2); a1 += __shfl_xor(a1, 1);
#pragma unroll
                for (int e = 0; e < 8; ++e) lg8[e] = __builtin_bit_cast(float, __builtin_amdgcn_readlane(__builtin_bit_cast(int, a1), e * 8));
            }
            int e0 = 0; float m0 = lg8[0];
#pragma unroll
            for (int e = 1; e < 8; ++e) if (lg8[e] > m0) { m0 = lg8[e]; e0 = e; }
            int e1 = -1; float m1 = -3.0e38f;
#pragma unroll
            for (int e = 0; e < 8; ++e) if (e != e0 && lg8[e] > m1) { m1 = lg8[e]; e1 = e; }
            if (e1 < 0) { e1 = (e0 + 1) & 7; m1 = m0; }
            const float w0 = 1.0f / (1.0f + __expf(m1 - m0)), w1 = 1.0f - w0;
            if (lane == 0) { f32x4 o; o[0] = __int_as_float(e0); o[1] = __int_as_float(e1); o[2] = w0; o[3] = w1; *(f32x4*)(route + (size_t)row * 4) = o; }
#pragma unroll
            for (int e = 0; e < 8; ++e) ecnt[e] += ((e0 == e) ? 1 : 0) + ((e1 == e) ? 1 : 0);
        }
    }
    if (router) {
        __syncthreads();
        LAS int* bc = (LAS int*)F.lds;
        if (tid < 8) bc[tid] = 0;
        __syncthreads();
        if (lane == 0) {
#pragma unroll
            for (int e = 0; e < 8; ++e) atomicAdd((int*)(bc + e), ecnt[e]); }
        __syncthreads();
        if (tid < 8) ((int*)(ws + WS_META + 4096))[F.bid * 8 + tid] = bc[tid];
        __syncthreads();
    }
}

__device__ __forceinline__ void ph_route_lists(const Frame& F, int l) {
    PH_LOCALS(F)
    const int row_lo = (l == 3) ? NCTX : 0, nrows = NTOK - row_lo, per = (nrows + F.G * 8 - 1) / (F.G * 8), rpb = per * 8;
    const int rb0 = row_lo + F.bid * rpb; const int rb1 = (rb0 + rpb < NTOK) ? rb0 + rpb : NTOK;
    LAS int* tot = (LAS int*)F.lds;
    LAS int* pre = tot + 8;
    LAS int* tb = pre + 8;
    LAS int* wc = tb + 16;
    const int* cnt = (const int*)(ws + WS_META + 4096);
    const int* route = (const int*)(ws + WS_ROUTE);
    int* meta = (int*)(ws + WS_META); int* list = (int*)(ws + WS_LIST);
    const float* rsc = (const float*)(ws + WS_RS); float* srs = (float*)(ws + WS_SRS);
    if (tid < 8) { int s = 0, p = 0; for (int b = 0; b < F.G; ++b) { const int c = cnt[b * 8 + tid]; if (b < F.bid) p += c; s += c; } tot[tid] = s; pre[tid] = p; }
    __syncthreads();
    if (tid == 0) { int s = 0; for (int e = 0; e < 8; ++e) { tb[e] = s; s += (tot[e] + 255) >> 8; } tb[8] = s;
        if (F.bid == 0) { for (int e = 0; e < 9; ++e) meta[e] = tb[e]; for (int e = 0; e < 8; ++e) meta[16 + e] = tot[e]; } }
    const int r = rb0 + wid * 64 + lane; const bool ok = r < rb1;
    int e0 = -1, e1 = -1; float myrs = 0.f;
    if (ok) { const u32x2 ee = *(const u32x2*)(route + (size_t)r * 4); e0 = (int)ee.x; e1 = (int)ee.y; myrs = rsc[r]; }
#pragma unroll
    for (int e = 0; e < 8; ++e) { const unsigned long long m0 = __ballot(e0 == e), m1 = __ballot(e1 == e); if (lane == 0) wc[wid * 8 + e] = __popcll(m0) + __popcll(m1); }
    __syncthreads();
    const unsigned long long lt = (1ull << lane) - 1ull;
#pragma unroll
    for (int e = 0; e < 8; ++e) { const unsigned long long m0 = __ballot(e0 == e), m1 = __ballot(e1 == e);
        int wp = 0; for (int w = 0; w < wid; ++w) wp += wc[w * 8 + e];
        const int base = tb[e] * 256 + pre[e] + wp;
        if (e0 == e) { const int p = base + __popcll(m0 & lt); list[p] = (r << 1); srs[p] = myrs; }
        if (e1 == e) { const int p = base + __popcll(m0) + __popcll(m1 & lt); list[p] = (r << 1) | 1; srs[p] = myrs; } }
    if (F.bid == 0 && tid < 8) { for (int p = tb[tid] * 256 + tot[tid]; p < tb[tid + 1] * 256; ++p) { list[p] = -1; srs[p] = 0.f; } }
    __syncthreads();
}

__device__ __forceinline__ void chunk_geom(int b, int dir, int c, int& rbase, int& cf) {
    if (dir == 0) { cf = c; rbase = (c < 4) ? b * 256 + 64 * c : NCTX + b * SEQ + 64 * (c - 4); }
    else { cf = (c < 4) ? 3 - c : 135 - c; rbase = (c < 4) ? b * 256 + 64 * (3 - c) : NCTX + b * SEQ + 64 * (131 - c); }
}
__device__ __forceinline__ u32x4 rev8(u32x4 v) {
    u32x4 r; r.x = (v.w >> 16) | (v.w << 16); r.y = (v.z >> 16) | (v.z << 16); r.z = (v.y >> 16) | (v.y << 16); r.w = (v.x >> 16) | (v.x << 16); return r;
}

__device__ __forceinline__ void ph_p0(const Frame& F, int l) {
    PH_LOCALS(F)
    const int fr = lane & 15, fq = lane >> 4;
    LAS bf16* Bq = (LAS bf16*)F.lds;
    LAS bf16* Bz = Bq + 64 * 136;
    LAS bf16* Bkr = Bz + 64 * 136;
    LAS bf16* Bqt = Bkr + 64 * 136;
    LAS bf16* Bv = Bqt + 64 * 136;
    LAS bf16* Bkh = Bv + 64 * 136;
    LAS bf16* Bfar = Bkh + 128 * 72;
    LAS bf16* Bas = Bfar + 3 * 16 * 136;
    LAS float* Fs = (LAS float*)(Bas + 64 * 72);
    const bf16* ZA = (const bf16*)(ws + WS_ZA); const bf16* ZB = (const bf16*)(ws + WS_ZB);
    const float* LB = (const float*)(ws + WS_LB);
    u32x4* QF = (u32x4*)(ws + WS_QF); u32x4* KF = (u32x4*)(ws + WS_KF); u32x4* AF = (u32x4*)(ws + WS_AF); u32x4* VF = (u32x4*)(ws + WS_VF);
    float* DEC = (float*)(ws + WS_DEC);
    u32x4 pq[2], pz[2];
#define P0_PRELOAD(u_) do { const int dir_ = (u_) & 1, h_ = ((u_) >> 1) & 3, bc_ = (u_) >> 3, c_ = NCHUNK - 1 - (bc_ >> 3), b_ = bc_ & 7; int rb_, cf_; chunk_geom(b_, dir_, c_, rb_, cf_); (void)cf_; \
        _Pragma("unroll") for (int i_ = 0; i_ < 2; ++i_) { const int p_ = tid + NTHR * i_, rr_ = p_ >> 4, c8_ = (p_ & 15) * 8; const int srow_ = rb_ + (dir_ ? 63 - rr_ : rr_); \
            pq[i_] = *(const u32x4*)(ZA + (size_t)srow_ * ZW + h_ * 128 + c8_); pz[i_] = *(const u32x4*)(ZA + (size_t)srow_ * ZW + 512 + dir_ * 512 + h_ * 128 + c8_); } } while (0)
    if (F.bid < NUNIT_P0) P0_PRELOAD(F.bid);
    for (int u = F.bid; u < NUNIT_P0; u += F.G) {
        const int dir = u & 1, h = (u >> 1) & 3, bc = u >> 3, c = NCHUNK - 1 - (bc >> 3), b = bc & 7;
        const int uo = ((b * 4 + h) * 2 + dir) * NCHUNK + c;
        int rbase, cf; chunk_geom(b, dir, c, rbase, cf);
#pragma unroll
        for (int i = 0; i < 2; ++i) { const int p = tid + NTHR * i, rr = p >> 4, c8 = (p & 15) * 8;
            *(LAS u32x4*)(Bq + rr * 136 + c8) = pq[i]; *(LAS u32x4*)(Bz + rr * 136 + c8) = pz[i]; }
        __syncthreads();
        if (u + F.G < NUNIT_P0) P0_PRELOAD(u + F.G);
        const int si = tid >> 7, k = tid & 127;
        float fv[16], kv[16], qp[16], kr[16];
        {
            const float lbv = LB[(l * 2 + dir) * 512 + h * 128 + k], oml = 1.0f - lbv;
            float p = 1.0f;
#pragma unroll
            for (int t = 0; t < 16; ++t) { const int idx = (16 * si + t) * 136 + k;
                const float zf = bf2f(Bz[idx]), q = bf2f(Bq[idx]);
                const float w = __expf(fminf(-zf, 80.0f)), r1 = __builtin_amdgcn_rcpf(1.0f + w);
                const float f = (1.0f + lbv * w) * r1, kk = oml * w * r1;
                p *= f; fv[t] = f; kv[t] = kk; qp[t] = q * QSCALE * p;
                Bq[idx] = f2bf(qp[t]); Bz[idx] = f2bf(kk * __builtin_amdgcn_rcpf(fmaxf(p, 1e-30f))); }
            Fs[si * 128 + k] = p;
            float r = 1.0f;
#pragma unroll
            for (int t = 15; t >= 0; --t) { kr[t] = kv[t] * r; r *= fv[t]; Bkr[(16 * si + t) * 136 + k] = f2bf(kr[t]); }
        }
        __syncthreads();
        {
            const float F0 = Fs[k], F1 = Fs[128 + k], F2 = Fs[256 + k], F3 = Fs[384 + k];
            const float Gm = si == 0 ? 1.0f : si == 1 ? F0 : si == 2 ? F0 * F1 : F0 * F1 * F2;
            const float Hm = si == 3 ? 1.0f : si == 2 ? F3 : si == 1 ? F2 * F3 : F1 * F2 * F3;
#pragma unroll
            for (int t = 0; t < 16; ++t) Bqt[(16 * si + t) * 136 + k] = f2bf(qp[t] * Gm);
#pragma unroll
            for (int t = 0; t < 16; t += 2) *(LAS unsigned*)(Bkh + k * 72 + 16 * si + t) = pk2(kr[t] * Hm, kr[t + 1] * Hm);
            if (si == 0) {
#pragma unroll
                for (int t = 0; t < 16; ++t) { Bfar[(0 * 16 + t) * 136 + k] = f2bf(kr[t] * F1); Bfar[(2 * 16 + t) * 136 + k] = f2bf(kr[t] * F1 * F2); }
                DEC[(size_t)uo * 128 + ((k >> 2) & 3) * 32 + (k >> 4) * 4 + (k & 3)] = F0 * F1 * F2 * F3; }
            if (si == 1) {
#pragma unroll
                for (int t = 0; t < 16; ++t) Bfar[(1 * 16 + t) * 136 + k] = f2bf(kr[t] * F2); }
        }
        __syncthreads();
        if (wid < 4) {
            const int rho = wid;
            for (int j = 0; j < 4; ++j) {
                if (j <= rho) {
                    const LAS bf16* Kx = (j == rho) ? Bz + 16 * j * 136 : (j == rho - 1) ? Bkr + 16 * j * 136 : Bfar + ((rho == 2) ? 0 : (j == 1 ? 1 : 2)) * 16 * 136;
                    f32x4 acc = (f32x4){0.f, 0.f, 0.f, 0.f};
#pragma unroll
                    for (int kq = 0; kq < 4; ++kq) { const bf16x8 av = *(const LAS bf16x8*)(Bq + (16 * rho + fr) * 136 + 32 * kq + 8 * fq); const bf16x8 bv = *(const LAS bf16x8*)(Kx + fr * 136 + 32 * kq + 8 * fq);
                        acc = __builtin_amdgcn_mfma_f32_16x16x32_bf16(av, bv, acc, 0, 0, 0); }
#pragma unroll
                    for (int e = 0; e < 4; ++e) { const float val = (j < rho || fr <= 4 * fq + e) ? acc[e] : 0.f; Bas[(16 * rho + 4 * fq + e) * 72 + 16 * j + fr] = f2bf(val); }
                } else {
#pragma unroll
                    for (int e = 0; e < 4; ++e) Bas[(16 * rho + 4 * fq + e) * 72 + 16 * j + fr] = 0;
                }
            }
        } else {
            const int w4 = wid - 4;
#pragma unroll
            for (int kq = 0; kq < 4; ++kq) { const int t = 16 * w4 + fr;
                const u32x2 lo = *(const LAS u32x2*)(Bqt + t * 136 + 32 * kq + 4 * fq), hi = *(const LAS u32x2*)(Bqt + t * 136 + 32 * kq + 16 + 4 * fq);
                QF[((size_t)uo * 16 + w4 * 4 + kq) * 64 + lane] = (u32x4){lo.x, lo.y, hi.x, hi.y}; }
#pragma unroll
            for (int dd = 0; dd < 2; ++dd)
#pragma unroll
                for (int sg = 0; sg < 2; ++sg) { const int d = 2 * w4 + dd, krow = 16 * d + fr;
                    const u32x4 vec = *(const LAS u32x4*)(Bkh + krow * 72 + 32 * sg + 8 * fq);
                    KF[((size_t)uo * 16 + d * 2 + sg) * 64 + lane] = vec; }
        }
        __syncthreads();
        if (wid < 6) {
            const int rho = wid < 2 ? wid : (wid < 4 ? 2 : 3), sl = (wid == 3 || wid == 5) ? 1 : 0; const int t = 16 * rho + fr;
            const u32x4 vec = *(const LAS u32x4*)(Bas + t * 72 + 32 * sl + 8 * fq);
            AF[((size_t)uo * 8 + wid) * 64 + lane] = vec;
        }
        __syncthreads();
    }
}

__device__ __forceinline__ void ph_pool1(const Frame& F, int pw, int npw) {
    PH_LOCALS(F)
    const bf16* ZB = (const bf16*)(ws + WS_ZB); bf16* P1 = (bf16*)(ws + WS_POOL1);
    const int g = lane >> 4, kwin = 2 << g, lo = kwin >> 1, hi = kwin - 1 - lo;
    const int nw = npw * 8;
#define P1_ACC(s_, v_, m_) do { (s_)[0] += (m_) * bflo((v_).x); (s_)[1] += (m_) * bfhi((v_).x); (s_)[2] += (m_) * bflo((v_).y); (s_)[3] += (m_) * bfhi((v_).y); (s_)[4] += (m_) * bflo((v_).z); (s_)[5] += (m_) * bfhi((v_).z); (s_)[6] += (m_) * bflo((v_).w); (s_)[7] += (m_) * bfhi((v_).w); } while (0)
#define P1_TAP(c_) (*(const u32x4*)(ZB + (size_t)(NCTX + tok0 + (c_)) * ZW + 1024 + lane * 8))
    for (int it = pw * 8 + wid; it < NLAT / 64; it += nw) {
        const int tok0 = it * 64;
        float s[8];
#pragma unroll
        for (int e = 0; e < 8; ++e) s[e] = 0.f;
        {
            u32x4 tv[8];
#pragma unroll
            for (int t = 0; t < 8; ++t) tv[t] = P1_TAP(t <= hi ? t : 0);
#pragma unroll
            for (int t = 0; t < 8; ++t) { const float mm = (t <= hi) ? 1.0f : 0.0f; P1_ACC(s, tv[t], mm); }
        }
        u32x4 a1 = P1_TAP(1 + hi <= 63 ? 1 + hi : 0), b1 = P1_TAP(0), a2 = P1_TAP(2 + hi <= 63 ? 2 + hi : 0), b2 = P1_TAP(1 - lo >= 0 ? 1 - lo : 0);
        for (int c = 0; c < 64; ++c) {
            u32x4 o; o.x = pk2(s[0], s[1]); o.y = pk2(s[2], s[3]); o.z = pk2(s[4], s[5]); o.w = pk2(s[6], s[7]);
            *(u32x4*)(P1 + (size_t)(tok0 + c) * 512 + lane * 8) = o;
            { const int cn = c + 1; const float ma = (cn + hi <= 63) ? 1.0f : 0.0f, mb = (cn - 1 - lo >= 0) ? -1.0f : 0.0f; P1_ACC(s, a1, ma); P1_ACC(s, b1, mb); }
            a1 = a2; b1 = b2;
            { const int cn = c + 3, ca = cn + hi, cb = cn - 1 - lo; a2 = P1_TAP((ca <= 63) ? ca : 0); b2 = P1_TAP((cb >= 0 && cb <= 63) ? cb : 0); }
        }
    }
#undef P1_ACC
#undef P1_TAP
}

__device__ __forceinline__ void ph_scan(const Frame& F, int l) {
    PH_LOCALS(F)
    const int fr = lane & 15, fq = lane >> 4, vt = wid;
    const u32x4* QF = (const u32x4*)(ws + WS_QF); const u32x4* KF = (const u32x4*)(ws + WS_KF); const u32x4* AF = (const u32x4*)(ws + WS_AF); const u32x4* VF = (const u32x4*)(ws + WS_VF);
    const float* DEC = (const float*)(ws + WS_DEC);
    bf16* O = (bf16*)(ws + WS_ZA);
    for (int chain = F.bid; chain < 64; chain += F.G) {
        const int b = chain >> 3, h = (chain >> 1) & 3, dir = chain & 1;
        f32x4 S[8];
#pragma unroll
        for (int d = 0; d < 8; ++d) S[d] = (f32x4){0.f, 0.f, 0.f, 0.f};
        for (int c = 0; c < NCHUNK; ++c) {
            const int uo = chain * NCHUNK + c; int rbase, cf; chunk_geom(b, dir, c, rbase, cf);
            const u32x4* qf = QF + (size_t)uo * 16 * 64 + lane; const u32x4* kf = KF + (size_t)uo * 16 * 64 + lane; const u32x4* af = AF + (size_t)uo * 8 * 64 + lane;
            const u32x4* vf = VF + ((size_t)((b * 4 + h) * NCHUNK + cf) * 16 + vt * 2) * 64 + lane;
            const f32x4* dc = (const f32x4*)(DEC + (size_t)uo * 128 + fq * 32);
            bf16x8 vv0 = __builtin_bit_cast(bf16x8, vf[0]), vv1 = __builtin_bit_cast(bf16x8, vf[64]);
            f32x4 o[4];
#pragma unroll
            for (int r = 0; r < 4; ++r) o[r] = (f32x4){0.f, 0.f, 0.f, 0.f};
            bf16x8 sf[4];
#pragma unroll
            for (int kq = 0; kq < 4; ++kq) { u32x4 p; p.x = pk2(S[2 * kq][0], S[2 * kq][1]); p.y = pk2(S[2 * kq][2], S[2 * kq][3]); p.z = pk2(S[2 * kq + 1][0], S[2 * kq + 1][1]); p.w = pk2(S[2 * kq + 1][2], S[2 * kq + 1][3]); sf[kq] = __builtin_bit_cast(bf16x8, p); }
#pragma unroll
            for (int r = 0; r < 4; ++r)
#pragma unroll
                for (int kq = 0; kq < 4; ++kq) { const bf16x8 qv = __builtin_bit_cast(bf16x8, qf[(r * 4 + kq) * 64]); o[r] = __builtin_amdgcn_mfma_f32_16x16x32_bf16(sf[kq], qv, o[r], 0, 0, 0); }
            const bf16x8 va = dir ? vv1 : vv0, vb = dir ? vv0 : vv1;
            { const bf16x8 a0 = __builtin_bit_cast(bf16x8, af[0]), a1 = __builtin_bit_cast(bf16x8, af[64]), a2 = __builtin_bit_cast(bf16x8, af[128]), a3 = __builtin_bit_cast(bf16x8, af[192]), a4 = __builtin_bit_cast(bf16x8, af[256]), a5 = __builtin_bit_cast(bf16x8, af[320]);
              o[0] = __builtin_amdgcn_mfma_f32_16x16x32_bf16(va, a0, o[0], 0, 0, 0);
              o[1] = __builtin_amdgcn_mfma_f32_16x16x32_bf16(va, a1, o[1], 0, 0, 0);
              o[2] = __builtin_amdgcn_mfma_f32_16x16x32_bf16(va, a2, o[2], 0, 0, 0);
              o[2] = __builtin_amdgcn_mfma_f32_16x16x32_bf16(vb, a3, o[2], 0, 0, 0);
              o[3] = __builtin_amdgcn_mfma_f32_16x16x32_bf16(va, a4, o[3], 0, 0, 0);
              o[3] = __builtin_amdgcn_mfma_f32_16x16x32_bf16(vb, a5, o[3], 0, 0, 0); }
#pragma unroll
            for (int r = 0; r < 4; ++r) { const int t = 16 * r + fr; const int row = rbase + (dir ? 63 - t : t);
                u32x2 w; w.x = pk2(o[r][0], o[r][1]); w.y = pk2(o[r][2], o[r][3]);
                *(u32x2*)(O + (size_t)row * 1024 + dir * 512 + h * 128 + 16 * vt + 4 * fq) = w; }
#pragma unroll
            for (int d = 0; d < 8; ++d) { S[d] = S[d] * dc[d];
                const bf16x8 k0 = __builtin_bit_cast(bf16x8, kf[(d * 2) * 64]), k1 = __builtin_bit_cast(bf16x8, kf[(d * 2 + 1) * 64]);
                S[d] = __builtin_amdgcn_mfma_f32_16x16x32_bf16(k0, vv0, S[d], 0, 0, 0);
                S[d] = __builtin_amdgcn_mfma_f32_16x16x32_bf16(k1, vv1, S[d], 0, 0, 0); }
        }
    }
}

constexpr int SC_QF = 0, SC_KF = 16384, SC_AF = 32768, SC_DEC = 38912, SC_VF = 39936, SC_SLOT = 48128;
#define SC_BAR() do { asm volatile("" ::: "memory"); __builtin_amdgcn_s_barrier(); asm volatile("" ::: "memory"); } while (0)
__device__ __forceinline__ void ph_scan2(const Frame& F, int l) {
    PH_LOCALS(F)
    const int fr = lane & 15, fq = lane >> 4;
    int sb, pw, npw;
    if (F.G == 256) { const int xcd = F.bid & 7, idx = F.bid >> 3; sb = idx < 16 ? xcd * 16 + idx : -1; pw = xcd * 16 + (idx - 16); npw = 128; }
    else { sb = F.bid < 128 ? F.bid : -1; pw = F.G > 128 ? F.bid - 128 : F.bid; npw = F.G > 128 ? F.G - 128 : F.G; }
    if (sb >= 0) {
        const int chain = sb >> 1, vhalf = sb & 1, b = chain >> 3, h = (chain >> 1) & 3, dir = chain & 1;
        if (wid >= 4) {
            const int lw = wid - 4;
            const char* gQF = (const char*)(ws + WS_QF) + (size_t)chain * NCHUNK * 16384 + lane * 16;
            const char* gKF = (const char*)(ws + WS_KF) + (size_t)chain * NCHUNK * 16384 + lane * 16;
            const char* gAF = (const char*)(ws + WS_AF) + (size_t)chain * NCHUNK * 8192 + lane * 16;
            const char* gDEC = (const char*)(ws + WS_DEC) + (size_t)chain * NCHUNK * 512 + lane * 16;
            const char* gV = (const char*)(ws + WS_ZB) + (size_t)(h * 128 + vhalf * 64) * 2 + (lane & 7) * 16;
#define SC_ISSUE(c_, slot_) do { const int cc_ = (c_) < NCHUNK ? (c_) : NCHUNK - 1; int rb_, cf_; chunk_geom(b, dir, cc_, rb_, cf_); (void)cf_; \
            _Pragma("unroll") for (int j_ = 0; j_ < 12; ++j_) { const int i_ = lw + 4 * j_; const char* src_; int off_; \
                if (i_ < 16) { src_ = gQF + (size_t)cc_ * 16384 + i_ * 1024; off_ = SC_QF + i_ * 1024; } \
                else if (i_ < 32) { src_ = gKF + (size_t)cc_ * 16384 + (i_ - 16) * 1024; off_ = SC_KF + (i_ - 16) * 1024; } \
                else if (i_ < 38) { src_ = gAF + (size_t)cc_ * 8192 + (i_ - 32) * 1024; off_ = SC_AF + (i_ - 32) * 1024; } \
                else if (i_ == 38 || i_ == 47) { src_ = gDEC + (size_t)cc_ * 512; off_ = SC_DEC; } \
                else { const int s_ = 8 * (i_ - 39) + (lane >> 3); src_ = gV + (size_t)(rb_ + (dir ? 63 - s_ : s_)) * (ZW * 2); off_ = SC_VF + (i_ - 39) * 1024; } \
                __builtin_amdgcn_global_load_lds((const unsigned*)src_, (LAS unsigned*)(F.lds + (slot_) * SC_SLOT + off_), 16, 0, 0); } } while (0)
            SC_ISSUE(0, 0); SC_ISSUE(1, 1);
            asm volatile("s_waitcnt vmcnt(12)" ::: "memory");
            SC_BAR();
            int slot = 2;
            for (int c = 0; c < NCHUNK; ++c) {
                SC_ISSUE(c + 2, slot);
                asm volatile("s_waitcnt vmcnt(12)" ::: "memory");
                SC_BAR();
                slot = slot == 2 ? 0 : slot + 1;
            }
            asm volatile("s_waitcnt vmcnt(0)" ::: "memory");
#undef SC_ISSUE
        } else {
            const int vt = vhalf * 4 + wid;
            bf16* O = (bf16*)(ws + WS_ZA);
            f32x4 S[8];
#pragma unroll
            for (int d = 0; d < 8; ++d) S[d] = (f32x4){0.f, 0.f, 0.f, 0.f};
            SC_BAR();
            int slot = 0;
            for (int c = 0; c < NCHUNK; ++c) {
                int rbase, cf; chunk_geom(b, dir, c, rbase, cf); (void)cf;
                const LAS unsigned char* sl = F.lds + slot * SC_SLOT + lane * 16;
                bf16x8 vv0, vv1;
                { const LAS bf16* vt_ = (const LAS bf16*)(F.lds + slot * SC_SLOT + SC_VF) + 16 * wid + fr;
#pragma unroll
                  for (int e = 0; e < 8; ++e) { vv0[e] = (short)vt_[(8 * fq + e) * 64]; vv1[e] = (short)vt_[(32 + 8 * fq + e) * 64]; } }
                f32x4 o[4];
#pragma unroll
                for (int r = 0; r < 4; ++r) o[r] = (f32x4){0.f, 0.f, 0.f, 0.f};
                bf16x8 sf[4];
#pragma unroll
                for (int kq = 0; kq < 4; ++kq) { u32x4 p; p.x = pk2(S[2 * kq][0], S[2 * kq][1]); p.y = pk2(S[2 * kq][2], S[2 * kq][3]); p.z = pk2(S[2 * kq + 1][0], S[2 * kq + 1][1]); p.w = pk2(S[2 * kq + 1][2], S[2 * kq + 1][3]); sf[kq] = __builtin_bit_cast(bf16x8, p); }
#pragma unroll
                for (int r = 0; r < 4; ++r)
#pragma unroll
                    for (int kq = 0; kq < 4; ++kq) { const bf16x8 qv = *(const LAS bf16x8*)(sl + SC_QF + (r * 4 + kq) * 1024); o[r] = __builtin_amdgcn_mfma_f32_16x16x32_bf16(sf[kq], qv, o[r], 0, 0, 0); }
                const bf16x8 va = vv0, vb = vv1;
                { const bf16x8 a0 = *(const LAS bf16x8*)(sl + SC_AF), a1 = *(const LAS bf16x8*)(sl + SC_AF + 1024), a2 = *(const LAS bf16x8*)(sl + SC_AF + 2048), a3 = *(const LAS bf16x8*)(sl + SC_AF + 3072), a4 = *(const LAS bf16x8*)(sl + SC_AF + 4096), a5 = *(const LAS bf16x8*)(sl + SC_AF + 5120);
                  o[0] = __builtin_amdgcn_mfma_f32_16x16x32_bf16(va, a0, o[0], 0, 0, 0);
                  o[1] = __builtin_amdgcn_mfma_f32_16x16x32_bf16(va, a1, o[1], 0, 0, 0);
                  o[2] = __builtin_amdgcn_mfma_f32_16x16x32_bf16(va, a2, o[2], 0, 0, 0);
                  o[2] = __builtin_amdgcn_mfma_f32_16x16x32_bf16(vb, a3, o[2], 0, 0, 0);
                  o[3] = __builtin_amdgcn_mfma_f32_16x16x32_bf16(va, a4, o[3], 0, 0, 0);
                  o[3] = __builtin_amdgcn_mfma_f32_16x16x32_bf16(vb, a5, o[3], 0, 0, 0); }
#pragma unroll
                for (int r = 0; r < 4; ++r) { const int t = 16 * r + fr; const int row = rbase + (dir ? 63 - t : t);
                    u32x2 w; w.x = pk2(o[r][0], o[r][1]); w.y = pk2(o[r][2], o[r][3]);
                    *(u32x2*)(O + (size_t)row * 1024 + dir * 512 + h * 128 + 16 * vt + 4 * fq) = w; }
                const LAS unsigned char* sd = F.lds + slot * SC_SLOT + SC_DEC + fq * 128;
#pragma unroll
                for (int d = 0; d < 8; ++d) { S[d] = S[d] * *(const LAS f32x4*)(sd + d * 16);
                    const bf16x8 k0 = *(const LAS bf16x8*)(sl + SC_KF + (d * 2) * 1024), k1 = *(const LAS bf16x8*)(sl + SC_KF + (d * 2 + 1) * 1024);
                    S[d] = __builtin_amdgcn_mfma_f32_16x16x32_bf16(k0, vv0, S[d], 0, 0, 0);
                    S[d] = __builtin_amdgcn_mfma_f32_16x16x32_bf16(k1, vv1, S[d], 0, 0, 0); }
                asm volatile("s_waitcnt lgkmcnt(0)" ::: "memory");
                SC_BAR();
                slot = slot == 2 ? 0 : slot + 1;
            }
        }
        __syncthreads();
    }
    if (sb < 0 || F.G <= 128) { ph_pool1(F, pw, npw); wprep_run(F, 1, l >> 1, (l & 1) * (WT_MOE / 2), ((l & 1) + 1) * (WT_MOE / 2), pw, npw); }
}

#define RO_FINISH(row_, of_, ob_, gg_, pv_, s_, inv_) do { \
        float o_[8], gv_[8]; \
        o_[0] = bflo((of_).x) + bflo((ob_).x); o_[1] = bfhi((of_).x) + bfhi((ob_).x); o_[2] = bflo((of_).y) + bflo((ob_).y); o_[3] = bfhi((of_).y) + bfhi((ob_).y); \
        o_[4] = bflo((of_).z) + bflo((ob_).z); o_[5] = bfhi((of_).z) + bfhi((ob_).z); o_[6] = bflo((of_).w) + bflo((ob_).w); o_[7] = bfhi((of_).w) + bfhi((ob_).w); \
        gv_[0] = bflo((gg_).x); gv_[1] = bfhi((gg_).x); gv_[2] = bflo((gg_).y); gv_[3] = bfhi((gg_).y); gv_[4] = bflo((gg_).z); gv_[5] = bfhi((gg_).z); gv_[6] = bflo((gg_).w); gv_[7] = bfhi((gg_).w); \
        float ss_ = 0.f; \
        _Pragma("unroll") for (int e = 0; e < 8; ++e) ss_ += o_[e] * o_[e]; \
        ss_ = row16_sum(ss_); \
        const float rs_ = rsqrtf(ss_ * (1.0f / 128.0f) + EPS); \
        float r_[8], pp_[8]; \
        _Pragma("unroll") for (int e = 0; e < 8; ++e) r_[e] = o_[e] * rs_ * nwv[e] * siluf(gv_[e]); \
        pp_[0] = ((s_)[0] * (inv_) - bflo((pv_).x)) * psc[0]; pp_[1] = ((s_)[1] * (inv_) - bfhi((pv_).x)) * psc[1]; pp_[2] = ((s_)[2] * (inv_) - bflo((pv_).y)) * psc[2]; pp_[3] = ((s_)[3] * (inv_) - bfhi((pv_).y)) * psc[3]; \
        pp_[4] = ((s_)[4] * (inv_) - bflo((pv_).z)) * psc[4]; pp_[5] = ((s_)[5] * (inv_) - bfhi((pv_).z)) * psc[5]; pp_[6] = ((s_)[6] * (inv_) - bflo((pv_).w)) * psc[6]; pp_[7] = ((s_)[7] * (inv_) - bfhi((pv_).w)) * psc[7]; \
        float am_ = 0.f; \
        _Pragma("unroll") for (int e = 0; e < 8; ++e) am_ = fmaxf(am_, fmaxf(fabsf(r_[e]), fabsf(pp_[e]))); \
        am_ = fmaxf(wave_max(am_), 1e-20f); \
        const float qs_ = 127.0f / am_; \
        if (lane == 0) ((float*)(ws + WS_RS))[row_] = am_ * (1.0f / 127.0f); \
        u32x2 wa_; wa_.x = pk4_i8(r_[0] * qs_, r_[1] * qs_, r_[2] * qs_, r_[3] * qs_); wa_.y = pk4_i8(r_[4] * qs_, r_[5] * qs_, r_[6] * qs_, r_[7] * qs_); \
        *(u32x2*)(R8 + (size_t)(row_) * 1024 + lane * 8) = wa_; \
        u32x2 wp_; wp_.x = pk4_i8(pp_[0] * qs_, pp_[1] * qs_, pp_[2] * qs_, pp_[3] * qs_); wp_.y = pk4_i8(pp_[4] * qs_, pp_[5] * qs_, pp_[6] * qs_, pp_[7] * qs_); \
        *(u32x2*)(R8 + (size_t)(row_) * 1024 + 512 + lane * 8) = wp_; } while (0)
#define RO_ACC(s_, v_, m_) do { (s_)[0] += (m_) * bflo((v_).x); (s_)[1] += (m_) * bfhi((v_).x); (s_)[2] += (m_) * bflo((v_).y); (s_)[3] += (m_) * bfhi((v_).y); (s_)[4] += (m_) * bflo((v_).z); (s_)[5] += (m_) * bfhi((v_).z); (s_)[6] += (m_) * bflo((v_).w); (s_)[7] += (m_) * bfhi((v_).w); } while (0)
__device__ __forceinline__ void ph_readout(const Frame& F, int l) {
    const Args& a = *F.a; PH_LOCALS(F)
    const bf16* O = (const bf16*)(ws + WS_ZA); const bf16* ZB = (const bf16*)(ws + WS_ZB); const bf16* P1 = (const bf16*)(ws + WS_POOL1);
    unsigned char* R8 = (unsigned char*)(ws + WS_R1);
    const int g = lane >> 4, kwin = 2 << g, lo = kwin >> 1, hi = kwin - 1 - lo;
    float nwv[8], psc[8];
#pragma unroll
    for (int e = 0; e < 8; ++e) { nwv[e] = a.in[IN_HNORMW][l * 512 + lane * 8 + e]; psc[e] = a.in[IN_PSCALE][l * 512 + lane * 8 + e]; }
    const int nw = F.G * 8, gw = F.bid * 8 + wid;
    struct Tok { u32x4 of, ob, gg, pv, pa, pb; };
#define RO_LOAD(T, r_) do { const int rowL_ = NCTX + tok0 + (r_) * 64; \
        (T).of = *(const u32x4*)(O + (size_t)rowL_ * 1024 + lane * 8); (T).ob = *(const u32x4*)(O + (size_t)rowL_ * 1024 + 512 + lane * 8); \
        (T).gg = *(const u32x4*)(ZB + (size_t)rowL_ * ZW + 512 + lane * 8); (T).pv = *(const u32x4*)(ZB + (size_t)rowL_ * ZW + 1024 + lane * 8); \
        const int ra_ = (r_) + hi, rb_ = (r_) - 1 - lo; \
        (T).pa = *(const u32x4*)(P1 + (size_t)(tok0 + (ra_ <= 127 ? ra_ : (r_)) * 64) * 512 + lane * 8); \
        (T).pb = *(const u32x4*)(P1 + (size_t)(tok0 + (rb_ >= 0 ? rb_ : (r_)) * 64) * 512 + lane * 8); } while (0)
    for (int it = gw; it < NB * 64 * 4; it += nw) {
        const int b = it >> 8, c = (it >> 2) & 63, r0 = (it & 3) * 32, tok0 = b * SEQ + c;
        const int c0 = (c - lo < 0) ? 0 : c - lo, c1 = (c + hi > 63) ? 63 : c + hi; const float ncol = (float)(c1 - c0 + 1);
        float s[8];
#pragma unroll
        for (int e = 0; e < 8; ++e) s[e] = 0.f;
        {
            const int g0 = (r0 - lo < 0) ? 0 : r0 - lo, g1 = (r0 + hi > 127) ? 127 : r0 + hi;
            u32x4 tv[16];
#pragma unroll
            for (int t = 0; t < 16; ++t) { const int rr = r0 - lo + t; const bool ok = (t < kwin) && rr >= g0 && rr <= g1; tv[t] = *(const u32x4*)(P1 + (size_t)(tok0 + (ok ? rr : r0) * 64) * 512 + lane * 8); }
#pragma unroll
            for (int t = 0; t < 16; ++t) { const int rr = r0 - lo + t; const float mm = ((t < kwin) && rr >= g0 && rr <= g1) ? 1.0f : 0.0f; RO_ACC(s, tv[t], mm); }
        }
        Tok cur, n1, n2;
        RO_LOAD(cur, r0); RO_LOAD(n1, r0 + 1); RO_LOAD(n2, r0 + 2);
        for (int r = r0; r < r0 + 32; ++r) {
            if (r > r0) { const float ma = (r + hi <= 127) ? 1.0f : 0.0f, mb = (r - 1 - lo >= 0) ? -1.0f : 0.0f; RO_ACC(s, cur.pa, ma); RO_ACC(s, cur.pb, mb); }
            const int g0 = (r - lo < 0) ? 0 : r - lo, g1 = (r + hi > 127) ? 127 : r + hi;
            const float inv = 1.0f / ((float)(g1 - g0 + 1) * ncol);
            const int row = NCTX + tok0 + r * 64;
            RO_FINISH(row, cur.of, cur.ob, cur.gg, cur.pv, s, inv);
            cur = n1; n1 = n2;
            if (r + 3 < r0 + 32) RO_LOAD(n2, r + 3);
        }
    }
    if (l < 3) for (int row = gw; row < NCTX; row += nw) {
        const u32x4 of = *(const u32x4*)(O + (size_t)row * 1024 + lane * 8), ob = *(const u32x4*)(O + (size_t)row * 1024 + 512 + lane * 8), gg = *(const u32x4*)(ZB + (size_t)row * ZW + 512 + lane * 8);
        const u32x4 pv = *(const u32x4*)(ZB + (size_t)row * ZW + 1024 + lane * 8);
        float s[8];
#pragma unroll
        for (int e = 0; e < 8; ++e) s[e] = 0.f;
        const int j = row & 255; const int j0 = (j - lo < 0) ? 0 : j - lo, j1 = (j + hi > 255) ? 255 : j + hi;
        u32x4 tv[16];
#pragma unroll
        for (int t = 0; t < 16; ++t) { const int jj = j - lo + t; const bool ok = (t < kwin) && jj >= j0 && jj <= j1; tv[t] = *(const u32x4*)(ZB + (size_t)(row - j + (ok ? jj : j)) * ZW + 1024 + lane * 8); }
#pragma unroll
        for (int t = 0; t < 16; ++t) { const int jj = j - lo + t; const float mm = ((t < kwin) && jj >= j0 && jj <= j1) ? 1.0f : 0.0f; RO_ACC(s, tv[t], mm); }
        const float inv = 1.0f / (float)(j1 - j0 + 1);
        RO_FINISH(row, of, ob, gg, pv, s, inv);
    }
#undef RO_LOAD
}
#undef RO_FINISH
#undef RO_ACC

constexpr int PH_FINAL = 49, PH_END = 50;
#ifndef PHMASK
#define PHMASK 0xFFFF
#endif
#define SITE(k) ((PM >> (k)) & 1)
#ifdef DBLMASK
#define NREP(k) (1 + ((a.dbl >> (k)) & 1))
#else
#define DBLMASK 0
#define NREP(k) 1
#endif
template <int PM> __global__ void __launch_bounds__(NTHR, 2) mega(Args a) {
    extern __shared__ __attribute__((aligned(16))) unsigned char lds_raw[];
    Frame F; F.a = &a; F.ws = a.ws; F.lds = (LAS unsigned char*)lds_raw; F.tid = threadIdx.x; F.lane = F.tid & 63; F.wid = __builtin_amdgcn_readfirstlane(F.tid >> 6); F.G = gridDim.x; F.bid = blockIdx.x;
    volatile LAS unsigned* MISC = (volatile LAS unsigned*)(F.lds + LDS_MISC);
    if (F.tid < 4) MISC[F.tid] = 0u;
    __syncthreads();
    const bool multi = (a.ph_hi - a.ph_lo) > 1;
    XcdBarrier bar; bar.bar = (unsigned*)(a.ws + WS_CTL) + 4096; bar.x = 0; bar.st = MISC;
    if (multi) bar = xcd_barrier_post((unsigned*)(a.ws + WS_CTL) + 4096, MISC);
#define SEAM() do { if (multi) xcd_barrier(bar); } while (0)
#define RUN(p) (a.ph_lo <= (p) && (p) < a.ph_hi)
    unsigned char* ws = a.ws;
    if (SITE(0) && RUN(0)) _Pragma("nounroll") for (int rep_ = 0; rep_ < NREP(0); ++rep_) { ph_prologue(F); SEAM(); }
    for (int l = 0; l < DEPTH; ++l) {
        const int pb = 1 + 12 * l;
        if (SITE(1) && RUN(pb + 0)) _Pragma("nounroll") for (int rep_ = 0; rep_ < NREP(1); ++rep_) { ph_norm<0>(F, l); SEAM(); }
        if (SITE(2) && RUN(pb + 1)) _Pragma("nounroll") for (int rep_ = 0; rep_ < NREP(2); ++rep_) {
            pg8::StaticOrder S; S.init(NTOK / 256, DIN / 256, F.G, F.bid);
            pg8::EpiZQ E{(bf16*)(ws + WS_ZA), ZW, 6, (size_t)(WS_ZB - WS_ZA) / 2, (const float*)(ws + WS_RS), 1.0f / Q_SW1};
            pg8::gemm_phase<pg8::EpiZQ, pg8::StaticOrder, false, true>(F.lds, (const bf16*)(ws + WS_R1), (const bf16*)(ws + WS_WIN + (size_t)l * DIN * D), D / 2, S, E, nullptr);
            SEAM();
        }
        if (SITE(3) && RUN(pb + 2)) _Pragma("nounroll") for (int rep_ = 0; rep_ < NREP(3); ++rep_) { ph_p0(F, l); SEAM(); }
        if (SITE(4) && RUN(pb + 3)) _Pragma("nounroll") for (int rep_ = 0; rep_ < NREP(4); ++rep_) { ph_scan2(F, l); SEAM(); }
        if (SITE(5) && RUN(pb + 4)) _Pragma("nounroll") for (int rep_ = 0; rep_ < NREP(5); ++rep_) { ph_readout(F, l); SEAM(); }
        if (SITE(6) && RUN(pb + 5)) _Pragma("nounroll") for (int rep_ = 0; rep_ < NREP(6); ++rep_) {
            const int row_lo = (l == 3) ? NCTX : 0;
            pg8::StaticOrder S; S.init((NTOK - row_lo) / 256, D / 256, F.G, F.bid);
            pg8::EpiResid E{ws, l == 0 ? a.in[IN_CTX] : nullptr, l == 0 ? a.in[IN_X] : nullptr, (const float*)(ws + WS_MODS) + (size_t)(l * 9) * 6144 + 2 * 1024, row_lo, 1.0f / Q_SW1, (const float*)(ws + WS_RS)};
            pg8::gemm_phase<pg8::EpiResid, pg8::StaticOrder, false, true>(F.lds, (const bf16*)(ws + WS_R1 + (size_t)row_lo * D), (const bf16*)(ws + WS_WOUT + (size_t)l * D * D), D / 2, S, E, nullptr);
            SEAM();
        }
        if (SITE(7) && RUN(pb + 6)) _Pragma("nounroll") for (int rep_ = 0; rep_ < NREP(7); ++rep_) { ph_norm<1>(F, l); SEAM(); }
        if ((l & 1) == 0) {
            if (SITE(8) && RUN(pb + 7)) _Pragma("nounroll") for (int rep_ = 0; rep_ < NREP(8); ++rep_) {
                pg8::StaticOrder S; S.init(NTOK / 256, DFF / 128, F.G, F.bid);
                pg8::EpiSwiGLUQ E{ws + WS_ACT, DFF, DFF / 128, (const float*)(ws + WS_RS), 1.0f / Q_SW1, Q_SA};
                pg8::gemm_phase<pg8::EpiSwiGLUQ, pg8::StaticOrder, false, true>(F.lds, (const bf16*)(ws + WS_R1), (const bf16*)(ws + WS_WF1 + (size_t)(l >> 1) * 2 * DFF * D), D / 2, S, E, nullptr);
                SEAM();
            }
            if (SITE(9) && RUN(pb + 8)) _Pragma("nounroll") for (int rep_ = 0; rep_ < NREP(9); ++rep_) {
                pg8::StaticOrder S; S.init(NTOK / 256, D / 256, F.G, F.bid);
                pg8::EpiResid E{ws, nullptr, nullptr, (const float*)(ws + WS_MODS) + (size_t)(l * 9) * 6144 + 5 * 1024, 0, 1.0f / (Q_SA * Q_SW2D), nullptr};
                pg8::gemm_phase<pg8::EpiResid, pg8::StaticOrder, false, true>(F.lds, (const bf16*)(ws + WS_ACT), (const bf16*)(ws + WS_WF2 + (size_t)(l >> 1) * D * DFF), DFF / 2, S, E, nullptr);
                SEAM();
            }
        } else {
            if (SITE(10) && RUN(pb + 7)) _Pragma("nounroll") for (int rep_ = 0; rep_ < NREP(10); ++rep_) { ph_route_lists(F, l); SEAM(); }
            {
                const int* meta = (const int*)(ws + WS_META); const int* list = (const int*)(ws + WS_LIST);
                if (SITE(11) && RUN(pb + 8)) _Pragma("nounroll") for (int rep_ = 0; rep_ < NREP(11); ++rep_) {
                    pg8::MoeOrder S; S.init(meta, DFE / 128, F.G, F.bid);
                    pg8::EpiSwiGLUQ E{ws + WS_ACT, DFE, DFE / 128, (const float*)(ws + WS_SRS), 1.0f / Q_SW1, Q_SA};
                    pg8::gemm_phase<pg8::EpiSwiGLUQ, pg8::MoeOrder, true, true>(F.lds, (const bf16*)(ws + WS_R1), (const bf16*)(ws + WS_WM1), D / 2, S, E, list);
                    SEAM();
                }
                if (SITE(12) && RUN(pb + 9)) _Pragma("nounroll") for (int rep_ = 0; rep_ < NREP(12); ++rep_) {
                    pg8::MoeOrder S; S.init(meta, D / 256, F.G, F.bid);
                    pg8::EpiScatter E{(bf16*)(ws + WS_YB), list, D / 256, 1.0f / (Q_SA * Q_SW2)};
                    pg8::gemm_phase<pg8::EpiScatter, pg8::MoeOrder, false, true>(F.lds, (const bf16*)(ws + WS_ACT), (const bf16*)(ws + WS_WM2), DFE / 2, S, E, nullptr);
                    SEAM();
                }
            }
        }
    }
#ifdef PROBE_READ
    if (SITE(14) && RUN(60)) {
        const int lane = F.lane, gw = F.bid * 8 + F.wid, per = (NLAT + F.G * 8 - 1) / (F.G * 8);
        f32x4 s = (f32x4){0.f, 0.f, 0.f, 0.f};
        for (int row = gw * per; row < gw * per + per && row < NLAT; ++row) {
#pragma unroll
            for (int i = 0; i < 4; ++i) s += *(const f32x4*)(a.in[IN_X] + (size_t)row * D + i * 256 + lane * 4); }
        if (s[0] + s[1] + s[2] + s[3] == 123.456f) ((float*)(ws + WS_META + 32768))[gw] = s[0];
    }
#endif
    if (SITE(13) && RUN(PH_FINAL)) ph_norm<2>(F, 3);
#undef SEAM
#undef RUN
}

#ifdef DBG_CUT
__global__ void dbg_dump(const bf16* src, size_t n_src, float* out, size_t n_out) {
#ifdef DBG_F32
    for (size_t i = (size_t)blockIdx.x * blockDim.x + threadIdx.x; i < n_out; i += (size_t)gridDim.x * blockDim.x) { float s = 1.0f; for (size_t j = i; j < n_src; j += n_out) s += ((const float*)src)[j]; out[i] = s; }
#else
    for (size_t i = (size_t)blockIdx.x * blockDim.x + threadIdx.x; i < n_out; i += (size_t)gridDim.x * blockDim.x) { float s = 0.f; for (size_t j = i; j < n_src; j += n_out) { const float x = bf2f(src[j]); s += (x - x == 0.0f) ? x : 1000.0f; } out[i] = s; }
#endif
}
#endif
#ifndef HOSTDBL
#define HOSTDBL 0
#endif
extern "C" void kernel_launch(void* const* d_in, const int* in_sizes, int n_in, void* d_out, int out_size, void* d_ws, size_t ws_size, hipStream_t stream) {
    static int grid = 0;
    if (grid == 0) {
        if (n_in != 21 || in_sizes[0] != NLAT * D || out_size != NLAT * D || ws_size < WS_END) {
            fprintf(stderr, "kernel_launch: unexpected shapes / workspace (n_in %d, in0 %d, out %d, ws %zu, need %zu); nothing launched\n", n_in, n_in > 0 ? in_sizes[0] : -1, out_size, ws_size, (size_t)WS_END); grid = -1; return; }
        int dev = 0, cus = 0, per_cu = 0;
        if (hipGetDevice(&dev) != hipSuccess || hipDeviceGetAttribute(&cus, hipDeviceAttributeMultiprocessorCount, dev) != hipSuccess) { grid = -1; return; }
#if MK_ONE_LAUNCH
        if (hipFuncSetAttribute((const void*)mega<PHMASK>, hipFuncAttributeMaxDynamicSharedMemorySize, LDS_BYTES) != hipSuccess) { fprintf(stderr, "kernel_launch: hipFuncSetAttribute failed\n"); grid = -1; return; }
        if (hipOccupancyMaxActiveBlocksPerMultiprocessor(&per_cu, (const void*)mega<PHMASK>, NTHR, LDS_BYTES) != hipSuccess || per_cu < 1) { fprintf(stderr, "kernel_launch: occupancy query says %d\n", per_cu); }
#else
        { const void* fs[15] = {(const void*)mega<1>, (const void*)mega<2>, (const void*)mega<4>, (const void*)mega<8>, (const void*)mega<16>, (const void*)mega<32>, (const void*)mega<64>, (const void*)mega<128>, (const void*)mega<256>, (const void*)mega<512>, (const void*)mega<1024>, (const void*)mega<2048>, (const void*)mega<4096>, (const void*)mega<8192>, (const void*)mega<16384>};
          for (int i = 0; i < 15; ++i) if (hipFuncSetAttribute(fs[i], hipFuncAttributeMaxDynamicSharedMemorySize, LDS_BYTES) != hipSuccess) { grid = -1; return; } }
        (void)per_cu;
#endif
        (void)hipGetLastError();
        grid = cus;
    }
    if (grid < 0) return;
#ifdef DBG_TRIVIAL
    hipMemsetAsync(d_out, 0, (size_t)out_size * 4, stream); return;
#endif
    if (hipMemsetAsync((char*)d_ws + WS_CTL, 0, CTL_BYTES, stream) != hipSuccess) return;
    Args a{};
    for (int i = 0; i < 21; ++i) a.in[i] = (const float*)d_in[i];
    a.out = (float*)d_out; a.ws = (unsigned char*)d_ws; a.dbl = DBLMASK;
#ifdef PROBE_READ
    { Args a2 = a; a2.ph_lo = 60; a2.ph_hi = 61; for (int r = 0; r < PROBE_READ; ++r) hipLaunchKernelGGL(mega<(1 << 14)>, dim3(grid), dim3(NTHR), LDS_BYTES, stream, a2); }
#endif
#if MK_ONE_LAUNCH
    a.ph_lo = 0; a.ph_hi = PH_END;
    hipLaunchKernelGGL(mega<PHMASK>, dim3(grid), dim3(NTHR), LDS_BYTES, stream, a);
#else
    for (int p = 0; p < PH_END; ++p) {
        if (p >= 1 && p < PH_FINAL) { const int l = (p - 1) / 12, j = (p - 1) % 12; if (((l & 1) == 0 && j > 8) || j > 9) continue; }
#ifdef DBG_CUT
        if (p >= DBG_CUT) break;
#endif
        a.ph_lo = p; a.ph_hi = p + 1;
        int site = 0;
        if (p == PH_FINAL) site = 13; else if (p >= 1) { const int l = (p - 1) / 12, j = (p - 1) % 12; site = (j <= 6) ? j + 1 : ((l & 1) == 0 ? j + 1 : (j == 7 ? 10 : (j == 8 ? 11 : 12))); }
        for (int rep = 0; rep < 1 + ((HOSTDBL >> site) & 1); ++rep) {
            switch (site) {
#define LSITE(k) case k: hipLaunchKernelGGL(mega<(1 << k)>, dim3(grid), dim3(NTHR), LDS_BYTES, stream, a); break;
                LSITE(14) LSITE(0) LSITE(1) LSITE(2) LSITE(3) LSITE(4) LSITE(5) LSITE(6) LSITE(7) LSITE(8) LSITE(9) LSITE(10) LSITE(11) LSITE(12) LSITE(13)
#undef LSITE
            } }
    }
#ifdef DBG_CUT
    hipLaunchKernelGGL(dbg_dump, dim3(2048), dim3(256), 0, stream, (const bf16*)((const char*)d_ws + DBG_SRC), (size_t)DBG_N, (float*)d_out, (size_t)out_size);
#endif
#endif
}
```
